# Optimizing an MI355X kernel written in HIP

```python
import jax, jax.numpy as jnp
from jax import lax
import numpy as np

D_MODEL = 1024
BATCH = 4
SEQ = 8192
DEPTH = 2

N_MIXERS = 2
N_HEADS = 16
N_KV_HEADS = 4
HEAD_DIM = D_MODEL // N_HEADS
GROUP = N_HEADS // N_KV_HEADS
QKV_DIM = (N_HEADS + 2 * N_KV_HEADS) * HEAD_DIM
WINDOW = 128
BLOCK = 128
ROPE_THETA = 10000.0
CONV_WIDTH = 31
CONV_HALF = CONV_WIDTH // 2
D_FF = 3584
N_EXPERTS = 8
TOP_K = 2
LN_EPS = 1e-5
N_EVEN = (DEPTH + 1) // 2
N_ODD = DEPTH // 2
DN_ALPHA = (2 * DEPTH) ** 0.25
DN_BETA = (8 * DEPTH) ** -0.25
NEG_INF = -1e30

kernel_name = 'hybrid_swa_conformer_moe_deepnorm'


def layer_norm(x, g, b):
    xf = x.astype(jnp.float32)
    mu = jnp.mean(xf, axis=-1, keepdims=True)
    var = jnp.mean(jnp.square(xf - mu), axis=-1, keepdims=True)
    y = (xf - mu) * lax.rsqrt(var + LN_EPS) * g.astype(jnp.float32) + b.astype(jnp.float32)
    return y.astype(x.dtype)


def rope(t, cos, sin):
    tf = t.astype(jnp.float32)
    t1, t2 = jnp.split(tf, 2, axis=-1)
    rot = jnp.concatenate([-t2, t1], axis=-1)
    return (tf * cos[None, :, None, :] + rot * sin[None, :, None, :]).astype(t.dtype)


def windowed_gqa(x, w_qkv, sink, w_o):
    B, S, _ = x.shape
    nb = S // BLOCK
    qkv = x @ w_qkv
    q, k, v = jnp.split(qkv, [N_HEADS * HEAD_DIM, (N_HEADS + N_KV_HEADS) * HEAD_DIM], axis=-1)
    q = q.reshape(B, S, N_HEADS, HEAD_DIM)
    k = k.reshape(B, S, N_KV_HEADS, HEAD_DIM)
    v = v.reshape(B, S, N_KV_HEADS, HEAD_DIM)
    pos = jnp.arange(S, dtype=jnp.float32)
    inv_freq = ROPE_THETA ** (-jnp.arange(0, HEAD_DIM, 2, dtype=jnp.float32) / HEAD_DIM)
    ang = pos[:, None] * inv_freq[None, :]
    ang = jnp.concatenate([ang, ang], axis=-1)
    cos, sin = jnp.cos(ang), jnp.sin(ang)
    q = rope(q, cos, sin).reshape(B, nb, BLOCK, N_KV_HEADS, GROUP, HEAD_DIM)
    k = rope(k, cos, sin)

    def band(t):
        tp = jnp.pad(t, ((0, 0), (BLOCK, BLOCK), (0, 0), (0, 0)))
        tp = tp.reshape(B, nb + 2, BLOCK, N_KV_HEADS, HEAD_DIM)
        return jnp.concatenate([tp[:, :-2], tp[:, 1:-1], tp[:, 2:]], axis=2)

    kb, vb = band(k), band(v)
    s = jnp.einsum('bnqkgd,bnjkd->bnkgqj', q, kb).astype(jnp.float32) * (HEAD_DIM ** -0.5)
    blk = jnp.arange(nb)[:, None, None] * BLOCK
    qpos = blk + jnp.arange(BLOCK)[None, :, None]
    kpos = blk - BLOCK + jnp.arange(3 * BLOCK)[None, None, :]
    valid = (jnp.abs(kpos - qpos) <= WINDOW) & (kpos >= 0) & (kpos < S)
    s = jnp.where(valid[None, :, None, None], s, NEG_INF)
    sk = sink.astype(jnp.float32).reshape(N_KV_HEADS, GROUP)[None, None, :, :, None, None]
    m = jnp.maximum(jnp.max(s, axis=-1, keepdims=True), sk)
    p = jnp.exp(s - m)
    p = p / (jnp.sum(p, axis=-1, keepdims=True) + jnp.exp(sk - m))
    o = jnp.einsum('bnkgqj,bnjkd->bnqkgd', p.astype(vb.dtype), vb)
    return o.reshape(B, S, N_HEADS * HEAD_DIM) @ w_o


def conformer_conv(x, pw1_w, pw1_b, dw_w, dw_b, norm_g, norm_b, pw2_w, pw2_b):
    h = x @ pw1_w + pw1_b
    a, g = jnp.split(h, 2, axis=-1)
    h = a * jax.nn.sigmoid(g)
    h = lax.conv_general_dilated(
        h, dw_w[:, None, :].astype(h.dtype), window_strides=(1,),
        padding=[(CONV_HALF, CONV_HALF)],
        dimension_numbers=('NWC', 'WIO', 'NWC'),
        feature_group_count=D_MODEL) + dw_b
    h = jax.nn.silu(layer_norm(h, norm_g, norm_b))
    return h @ pw2_w + pw2_b


def swiglu(x, w_gate, w_up, w_down):
    return (jax.nn.silu(x @ w_gate) * (x @ w_up)) @ w_down


def moe_swiglu(x, router, w_gate, w_up, w_down):
    B, S, D = x.shape
    xt = x.reshape(B * S, D)
    logits = (xt @ router).astype(jnp.float32)
    top_v, top_i = lax.top_k(logits, TOP_K)
    gates = jax.nn.softmax(top_v, axis=-1)
    combine = jnp.sum(jax.nn.one_hot(top_i, N_EXPERTS, dtype=jnp.float32) * gates[..., None], axis=1)
    y = jnp.zeros((B * S, D), jnp.float32)
    for e in range(N_EXPERTS):
        y = y + combine[:, e:e + 1] * swiglu(xt, w_gate[e], w_up[e], w_down[e]).astype(jnp.float32)
    return y.astype(x.dtype).reshape(B, S, D)


def setup_inputs(seed: int = 0) -> dict:
    key = jax.random.key(seed)
    ks = jax.random.split(key, 24)
    f32 = jnp.float32

    def nrm(k, shape, scale):
        return jax.random.normal(k, shape, f32) * scale

    d_in = D_MODEL ** -0.5
    w_qk = nrm(ks[1], (N_EVEN, D_MODEL, (N_HEADS + N_KV_HEADS) * HEAD_DIM), d_in)
    w_v = nrm(ks[2], (N_EVEN, D_MODEL, N_KV_HEADS * HEAD_DIM), d_in * DN_BETA)
    return {
        'x': jax.random.normal(ks[0], (BATCH, SEQ, D_MODEL), f32),
        'attn_w_qkv': jnp.concatenate([w_qk, w_v], axis=-1),
        'attn_sink': nrm(ks[3], (N_EVEN, N_HEADS), 0.5),
        'attn_w_o': nrm(ks[4], (N_EVEN, N_HEADS * HEAD_DIM, D_MODEL), d_in * DN_BETA),
        'conv_pw1_w': nrm(ks[5], (N_ODD, D_MODEL, 2 * D_MODEL), d_in),
        'conv_pw1_b': nrm(ks[6], (N_ODD, 2 * D_MODEL), 0.02),
        'conv_dw_w': nrm(ks[7], (N_ODD, CONV_WIDTH, D_MODEL), CONV_WIDTH ** -0.5),
        'conv_dw_b': nrm(ks[8], (N_ODD, D_MODEL), 0.02),
        'conv_norm_g': 1.0 + nrm(ks[9], (N_ODD, D_MODEL), 0.02),
        'conv_norm_b': nrm(ks[10], (N_ODD, D_MODEL), 0.02),
        'conv_pw2_w': nrm(ks[11], (N_ODD, D_MODEL, D_MODEL), d_in * DN_BETA),
        'conv_pw2_b': nrm(ks[12], (N_ODD, D_MODEL), 0.02),
        'ffn_w_gate': nrm(ks[13], (N_EVEN, D_MODEL, D_FF), d_in),
        'ffn_w_up': nrm(ks[14], (N_EVEN, D_MODEL, D_FF), d_in),
        'ffn_w_down': nrm(ks[15], (N_EVEN, D_FF, D_MODEL), D_FF ** -0.5 * DN_BETA),
        'moe_router': nrm(ks[16], (N_ODD, D_MODEL, N_EXPERTS), d_in),
        'moe_w_gate': nrm(ks[17], (N_ODD, N_EXPERTS, D_MODEL, D_FF), d_in),
        'moe_w_up': nrm(ks[18], (N_ODD, N_EXPERTS, D_MODEL, D_FF), d_in),
        'moe_w_down': nrm(ks[19], (N_ODD, N_EXPERTS, D_FF, D_MODEL), D_FF ** -0.5 * DN_BETA),
        'ln_mix_g': 1.0 + nrm(ks[20], (DEPTH, D_MODEL), 0.02),
        'ln_mix_b': nrm(ks[21], (DEPTH, D_MODEL), 0.02),
        'ln_ffn_g': 1.0 + nrm(ks[22], (DEPTH, D_MODEL), 0.02),
        'ln_ffn_b': nrm(ks[23], (DEPTH, D_MODEL), 0.02),
    }


def reference(x, attn_w_qkv, attn_sink, attn_w_o, conv_pw1_w, conv_pw1_b, conv_dw_w, conv_dw_b,
              conv_norm_g, conv_norm_b, conv_pw2_w, conv_pw2_b, ffn_w_gate, ffn_w_up, ffn_w_down,
              moe_router, moe_w_gate, moe_w_up, moe_w_down, ln_mix_g, ln_mix_b, ln_ffn_g, ln_ffn_b):
    for i in range(DEPTH):
        j = i // N_MIXERS
        if i % N_MIXERS == 0:
            mix = windowed_gqa(x, attn_w_qkv[j], attn_sink[j], attn_w_o[j])
        else:
            mix = conformer_conv(x, conv_pw1_w[j], conv_pw1_b[j], conv_dw_w[j], conv_dw_b[j],
                                 conv_norm_g[j], conv_norm_b[j], conv_pw2_w[j], conv_pw2_b[j])
        x = layer_norm(DN_ALPHA * x + mix, ln_mix_g[i], ln_mix_b[i])
        if i % 2 == 0:
            ffn = swiglu(x, ffn_w_gate[j], ffn_w_up[j], ffn_w_down[j])
        else:
            ffn = moe_swiglu(x, moe_router[j], moe_w_gate[j], moe_w_up[j], moe_w_down[j])
        x = layer_norm(DN_ALPHA * x + ffn, ln_ffn_g[i], ln_ffn_b[i])
    return x
```

```cpp
#include <hip/hip_runtime.h>
#include <cstdio>
#include <cstdint>
#include <cmath>

#ifndef PROBE_SPLIT
#define PROBE_SPLIT 0
#endif
#ifndef HBLK
#define HBLK 1
#endif
#ifndef MK_N_LAUNCHES
#define MK_N_LAUNCHES 1
#endif

namespace pg8 {
#define PG8_LAS __attribute__((address_space(3)))
typedef unsigned short bf16_t;
typedef short bf16x8 __attribute__((ext_vector_type(8)));
typedef float f32x4 __attribute__((ext_vector_type(4)));
typedef float f32x2 __attribute__((ext_vector_type(2)));
typedef unsigned u32x4 __attribute__((ext_vector_type(4)));
typedef unsigned u32x2 __attribute__((ext_vector_type(2)));
constexpr int BM = 256, BK = 64, HALF = 128, HTB = HALF * BK * 2, STAGE_BYTES = 8 * HTB, NXCD = 8, WGM = 8;

__host__ __device__ __forceinline__ int lds_byte(int r, int c) { const int st = (r >> 4) * 2 + (c >> 5), rr = r & 15, cc = c & 31, ob = rr * 64 + cc * 2; return st * 1024 + (ob ^ (((ob >> 9) & 1) << 5)); }
__host__ __device__ __forceinline__ void stage_rc(int b, int& R, int& C) { const int st = b / 1024, sb = b % 1024, swz = sb ^ (((sb >> 9) & 1) << 5); R = (st >> 1) * 16 + swz / 64; C = (st & 1) * 32 + (swz % 64) / 2; }
__host__ __device__ __forceinline__ int perm32(int rho) { const int n = rho >> 4, i = rho & 15; return 8 * (i >> 2) + 4 * n + (i & 3); }

struct Unit { int pm, pn, e; };
__host__ __device__ __forceinline__ size_t blk_off8(int row, int kb, int Kb) { return ((size_t)(row >> 8) * (Kb >> 7) + (kb >> 7)) * 32768 + (row & 255) * 128 + (kb & 127); }
struct Gemm { const bf16_t* A; const bf16_t* Bt; int K; size_t estride; int ablk; };

struct StaticOrder {
    int nM, nN, nwg, G, c; int i0 = 0, i1 = 1 << 30;
    __device__ __forceinline__ void init(int nM_, int nN_, int G_, int c_) { nM = nM_; nN = nN_; nwg = nM * nN; G = G_; c = c_; }
    __device__ __forceinline__ bool next(int i, Unit& u) const {
        if (i + i0 >= i1) return false; const long L = (long)(i + i0) * G + c; if (L >= nwg) return false;
        int wgid = (int)L; { const int q = nwg / NXCD, r = nwg % NXCD, xcd = wgid % NXCD, off = wgid / NXCD; wgid = (xcd < r ? xcd * (q + 1) : r * (q + 1) + (xcd - r) * q) + off; }
        const int nig = WGM * nN, gid = wgid / nig, fm = gid * WGM, gsz = (nM - fm) < WGM ? (nM - fm) : WGM;
        u.pm = fm + ((wgid % nig) % gsz); u.pn = (wgid % nig) / gsz; u.e = 0; return true;
    }
};
struct MoeOrder {
    StaticOrder so; int t0; int ts[9];
    __device__ __forceinline__ bool next(int i, Unit& u) const {
        if (!so.next(i, u)) return false;
        const int gt = t0 + u.pm; int e = 0;
#pragma unroll
        for (int j = 1; j < 8; ++j) e += (gt >= ts[j]) ? 1 : 0;
        u.e = e; return true;
    }
};

__device__ __forceinline__ unsigned cvt_pk_bf16(float lo, float hi) { unsigned r; asm volatile("v_cvt_pk_bf16_f32 %0, %1, %2" : "=v"(r) : "v"(lo), "v"(hi)); return r; }

typedef int i32x8 __attribute__((ext_vector_type(8)));
typedef int i32x4 __attribute__((ext_vector_type(4)));
__device__ __forceinline__ i32x8 cat8(bf16x8 a, bf16x8 b) { const i32x4 x = __builtin_bit_cast(i32x4, a), y = __builtin_bit_cast(i32x4, b); return (i32x8){x[0], x[1], x[2], x[3], y[0], y[1], y[2], y[3]}; }
__device__ __forceinline__ const char* addp(const char* base, unsigned off) {
    const unsigned long long b = (unsigned long long)base; const unsigned blo = (unsigned)b, bhi = (unsigned)(b >> 32); unsigned lo, hi;
    asm volatile("v_add_co_u32 %0, vcc, %2, %3\n\tv_addc_co_u32 %1, vcc, %4, 0, vcc" : "=&v"(lo), "=v"(hi) : "s"(blo), "v"(off), "s"(bhi) : "vcc");
    return (const char*)(((unsigned long long)hi << 32) | lo);
}
__device__ __forceinline__ float clamp448(float v) { return __builtin_fminf(__builtin_fmaxf(v, -448.f), 448.f); }
__device__ __forceinline__ unsigned pk4_fp8(float a, float b, float c, float d) {
    int r = __builtin_amdgcn_cvt_pk_fp8_f32(clamp448(a), clamp448(b), 0, false); r = __builtin_amdgcn_cvt_pk_fp8_f32(clamp448(c), clamp448(d), r, true); return (unsigned)r; }
typedef float f32x16 __attribute__((ext_vector_type(16)));
typedef unsigned u32x6 __attribute__((ext_vector_type(6)));
__device__ __forceinline__ void cvt_block6(const f32x16& a, const f32x16& b, u32x4& c0, u32x4& c1) {
    float mx = 0.f;
#pragma unroll
    for (int i = 0; i < 16; ++i) mx = __builtin_fmaxf(mx, __builtin_fmaxf(__builtin_fabsf(a[i]), __builtin_fabsf(b[i])));
    int e = (int)((__float_as_uint(mx * 1.0666667f) >> 23) & 0xffu) - 127 - 2;
    e = e < -100 ? -100 : (e > 100 ? 100 : e);
    const float inv = __uint_as_float((unsigned)(127 - e) << 23);
    f32x16 x, y;
#pragma unroll
    for (int i = 0; i < 16; ++i) { x[i] = __builtin_fminf(__builtin_fmaxf(a[i] * inv, -7.5f), 7.5f); y[i] = __builtin_fminf(__builtin_fmaxf(b[i] * inv, -7.5f), 7.5f); }
    const u32x6 r = __builtin_amdgcn_cvt_scalef32_2xpk16_fp6_f32(x, y, 1.0f);
    c0 = (u32x4){r[0], r[1], r[2], r[3]}; c1 = (u32x4){r[4], r[5], (unsigned)(e + 127), 0u};
}
#ifndef WT_STORES
#define WT_STORES 0
#endif
__device__ __forceinline__ void st16(void* p, u32x4 v) {
#if WT_STORES
    asm volatile("global_store_dwordx4 %0, %1, off sc1" :: "v"(p), "v"(v) : "memory");
#else
    *(u32x4*)p = v;
#endif
}
__device__ __forceinline__ void st8(void* p, u32x2 v) {
#if WT_STORES
    asm volatile("global_store_dwordx2 %0, %1, off sc1" :: "v"(p), "v"(v) : "memory");
#else
    *(u32x2*)p = v;
#endif
}

struct EpiQKV {
    static constexpr bool PERM = true;
    bf16_t* O; const float* ctab; const float* stab; float qscale;
    __device__ __forceinline__ void operator()(const f32x4 (&acc)[2][2][4][2], const Unit& u, int wr, int wc, int fr, int fq) const {
        const int row0 = u.pm * BM + wr * 64 + fr, col0 = u.pn * BM + wc * 32 + 8 * fq;
        const int j0 = 16 * (wc & 1) + 4 * fq;
        const bool rope = u.pn < 5; const float sc = u.pn < 4 ? qscale : 1.f;
#pragma unroll
        for (int ai = 0; ai < 2; ++ai)
#pragma unroll
            for (int m = 0; m < 4; ++m) {
                const int row = row0 + ai * HALF + m * 16; const int pos = row & 8191;
                f32x4 cs = (f32x4){1.f, 1.f, 1.f, 1.f}, sn = (f32x4){0.f, 0.f, 0.f, 0.f};
                if (rope) { cs = *(const f32x4*)(ctab + pos * 32 + j0); sn = *(const f32x4*)(stab + pos * 32 + j0); }
                bf16_t* rowp = O + (size_t)row * 1536 + col0;
#pragma unroll
                for (int bj = 0; bj < 2; ++bj) {
                    const f32x4 v0 = acc[ai][bj][m][0], v1 = acc[ai][bj][m][1];
                    const f32x4 o0 = (v0 * cs - v1 * sn) * sc, o1 = (v1 * cs + v0 * sn) * sc;
                    u32x4 w; w.x = cvt_pk_bf16(o0[0], o0[1]); w.y = cvt_pk_bf16(o0[2], o0[3]); w.z = cvt_pk_bf16(o1[0], o1[1]); w.w = cvt_pk_bf16(o1[2], o1[3]);
                    st16(rowp + bj * HALF, w); }
            }
    }
};
__device__ __forceinline__ float sigmoidf_fast(float x) { return __builtin_amdgcn_rcpf(1.f + __builtin_amdgcn_exp2f(-1.4426950408889634f * x)); }
template <int MODE> struct EpiGated {
    static constexpr bool PERM = true;
    bf16_t* O; int ldo; const float* bias; int bias_half; int oblk;
    __device__ __forceinline__ void operator()(const f32x4 (&acc)[2][2][4][2], const Unit& u, int wr, int wc, int fr, int fq) const {
        const int row0 = u.pm * BM + wr * 64 + fr, col0 = u.pn * HALF + wc * 16 + 4 * fq;
        f32x4 ba[2], bb[2];
#pragma unroll
        for (int bj = 0; bj < 2; ++bj) { if (MODE == 1) { ba[bj] = *(const f32x4*)(bias + col0 + bj * 64); bb[bj] = *(const f32x4*)(bias + bias_half + col0 + bj * 64); } else { ba[bj] = (f32x4){0.f, 0.f, 0.f, 0.f}; bb[bj] = ba[bj]; } }
#pragma unroll
        for (int ai = 0; ai < 2; ++ai)
#pragma unroll
            for (int m = 0; m < 4; ++m) {
                const int row = row0 + ai * HALF + m * 16;
                bf16_t* rowp = oblk ? O + ((size_t)(row >> 8) * (ldo >> 6) + (col0 >> 6)) * 16384 + (row & 255) * 64 + (col0 & 63) : O + (size_t)row * ldo + col0;
                const int bjs = oblk ? 16384 : 64;
#pragma unroll
                for (int bj = 0; bj < 2; ++bj) {
                    const f32x4 a = acc[ai][bj][m][0] + ba[bj], b = acc[ai][bj][m][1] + bb[bj]; f32x4 o;
#pragma unroll
                    for (int i = 0; i < 4; ++i) o[i] = (MODE == 0) ? a[i] * sigmoidf_fast(a[i]) * b[i] : a[i] * sigmoidf_fast(b[i]);
                    u32x2 w; w.x = cvt_pk_bf16(o[0], o[1]); w.y = cvt_pk_bf16(o[2], o[3]);
                    st8(rowp + bj * bjs, w); }
            }
    }
};
struct EpiGated8 {
    static constexpr bool PERM = true;
    unsigned char* O; int ldo; float inv, hs;
    __device__ __forceinline__ void operator()(const f32x4 (&acc)[2][2][4][2], const Unit& u, int wr, int wc, int fr, int fq) const {
        const int row0 = u.pm * BM + wr * 64 + fr, col0 = u.pn * HALF + wc * 32 + 8 * fq;
#pragma unroll
        for (int ai = 0; ai < 2; ++ai)
#pragma unroll
            for (int m = 0; m < 4; ++m) {
                unsigned char* rowp = O + blk_off8(row0 + ai * HALF + m * 16, col0, ldo); u32x2 w;
#pragma unroll
                for (int bj = 0; bj < 2; ++bj) { const f32x4 a = acc[ai][bj][m][0] * inv, b = acc[ai][bj][m][1] * inv; f32x4 o;
#pragma unroll
                    for (int i = 0; i < 4; ++i) o[i] = a[i] * sigmoidf_fast(a[i]) * b[i] * hs;
                    const unsigned p = pk4_fp8(o[0], o[1], o[2], o[3]); if (bj == 0) w.x = p; else w.y = p; }
                st8(rowp, w);
            }
    }
};
template <bool RESB> struct EpiResBf16 {
    static constexpr bool PERM = true;
    bf16_t* O; const void* res; const float* bias; float alpha;
    __device__ __forceinline__ void operator()(const f32x4 (&acc)[2][2][4][2], const Unit& u, int wr, int wc, int fr, int fq) const {
        const int row0 = u.pm * BM + wr * 64 + fr, col0 = u.pn * BM + wc * 32 + 8 * fq;
        f32x4 bv[2][2];
#pragma unroll
        for (int bj = 0; bj < 2; ++bj)
#pragma unroll
            for (int n = 0; n < 2; ++n) bv[bj][n] = bias ? *(const f32x4*)(bias + col0 + bj * HALF + 4 * n) : (f32x4){0.f, 0.f, 0.f, 0.f};
#pragma unroll
        for (int ai = 0; ai < 2; ++ai)
#pragma unroll
            for (int m = 0; m < 4; ++m) {
                const size_t off = (size_t)(row0 + ai * HALF + m * 16) * 1024 + col0;
#pragma unroll
                for (int bj = 0; bj < 2; ++bj) {
                    f32x4 r0, r1;
                    if (RESB) { const u32x4 w = *(const u32x4*)((const bf16_t*)res + off + bj * HALF);
                        r0 = (f32x4){__uint_as_float(w.x << 16), __uint_as_float(w.x & 0xffff0000u), __uint_as_float(w.y << 16), __uint_as_float(w.y & 0xffff0000u)};
                        r1 = (f32x4){__uint_as_float(w.z << 16), __uint_as_float(w.z & 0xffff0000u), __uint_as_float(w.w << 16), __uint_as_float(w.w & 0xffff0000u)}; }
                    else { r0 = *(const f32x4*)((const float*)res + off + bj * HALF); r1 = *(const f32x4*)((const float*)res + off + bj * HALF + 4); }
                    const f32x4 v0 = r0 * alpha + acc[ai][bj][m][0] + bv[bj][0], v1 = r1 * alpha + acc[ai][bj][m][1] + bv[bj][1];
                    u32x4 w; w.x = cvt_pk_bf16(v0[0], v0[1]); w.y = cvt_pk_bf16(v0[2], v0[3]); w.z = cvt_pk_bf16(v1[0], v1[1]); w.w = cvt_pk_bf16(v1[2], v1[3]);
                    st16(O + off + bj * HALF, w); }
            }
    }
};
struct EpiPlainBf16 {
    static constexpr bool PERM = true;
    bf16_t* O; int ldo; float sc;
    __device__ __forceinline__ void operator()(const f32x4 (&acc)[2][2][4][2], const Unit& u, int wr, int wc, int fr, int fq) const {
        const int row0 = u.pm * BM + wr * 64 + fr, col0 = u.pn * BM + wc * 32 + 8 * fq;
#pragma unroll
        for (int ai = 0; ai < 2; ++ai)
#pragma unroll
            for (int m = 0; m < 4; ++m) { bf16_t* rowp = O + (size_t)(row0 + ai * HALF + m * 16) * ldo + col0;
#pragma unroll
                for (int bj = 0; bj < 2; ++bj) { const f32x4 v0 = acc[ai][bj][m][0] * sc, v1 = acc[ai][bj][m][1] * sc;
                    u32x4 w; w.x = cvt_pk_bf16(v0[0], v0[1]); w.y = cvt_pk_bf16(v0[2], v0[3]); w.z = cvt_pk_bf16(v1[0], v1[1]); w.w = cvt_pk_bf16(v1[2], v1[3]);
                    st16(rowp + bj * HALF, w); } }
    }
};

template <int MODE, class Epi, class Sched>
__device__ __forceinline__ void gemm_phase(PG8_LAS unsigned char* lds, const Gemm g, const Sched& S, const Epi& E) {
    const int tid = threadIdx.x, wid = __builtin_amdgcn_readfirstlane(tid >> 6), lane = tid & 63, wr = wid >> 2, wc = wid & 3, fr = lane & 15, fq = lane >> 4;
    constexpr bool F8 = (MODE != 0);
    const int K = g.K, nt = K / BK;
    unsigned voffA[2], voffB[2];
#pragma unroll
    for (int i = 0; i < 2; ++i) { int R, C; stage_rc(tid * 16 + i * 8192, R, C); const int Rb = Epi::PERM ? ((R & ~31) + perm32(R & 31)) : R;
        voffA[i] = g.ablk ? (unsigned)(R * 128 + C * 2) : (unsigned)(R * K + C) * 2u; voffB[i] = (unsigned)(Rb * K + C) * 2u; }
    const unsigned kstep = (unsigned)(BK * 2);
    const unsigned hstep = (unsigned)HALF * (unsigned)K * 2u;
    const unsigned tstep = 2u * hstep;
    const unsigned kstepA = g.ablk ? 32768u : kstep, hstepA = g.ablk ? 16384u : hstep;
    const unsigned ldsw = (unsigned)wid * 1024u;
    const int aoff = lds_byte(wr * 64 + fr, fq * 8), boff = lds_byte(wc * 32 + fr, fq * 8);
    __amdgpu_buffer_rsrc_t rsA = __builtin_amdgcn_make_buffer_rsrc((void*)g.A, 0, 0x7fffffff, 0x00020000), rsB = __builtin_amdgcn_make_buffer_rsrc((void*)g.Bt, 0, 0x7fffffff, 0x00020000);
#define PG8_SA(b, h) (((b) * 2 + (h)) * HTB)
#define PG8_SB(b, h) ((4 + (b) * 2 + (h)) * HTB)
#define PG8_STAGE(bufoff, isA, uoff, voff) do { _Pragma("unroll") for (int _i = 0; _i < 2; ++_i) { \
        if constexpr (F8) __builtin_amdgcn_raw_ptr_buffer_load_lds((isA) ? rsA : rsB, (PG8_LAS void*)(lds + (bufoff) + ldsw + _i * 8192), 16, (voff)[_i], (uoff), 0, 0); \
        else __builtin_amdgcn_global_load_lds((const unsigned*)((const char*)((isA) ? (const void*)g.A : (const void*)g.Bt) + (size_t)(uoff) + (voff)[_i]), (PG8_LAS unsigned*)(lds + (bufoff) + ldsw + _i * 8192), 16, 0, 0); } } while (0)
#define PG8_LDA(dst, b, h) do { _Pragma("unroll") for (int m = 0; m < 4; ++m) _Pragma("unroll") for (int k = 0; k < 2; ++k) dst[m][k] = *(const PG8_LAS bf16x8*)(lds + PG8_SA(b, h) + aoff + m * 2048 + k * 1024); } while (0)
#define PG8_LDB(dst, b, h) do { _Pragma("unroll") for (int n = 0; n < 2; ++n) _Pragma("unroll") for (int k = 0; k < 2; ++k) dst[n][k] = *(const PG8_LAS bf16x8*)(lds + PG8_SB(b, h) + boff + n * 2048 + k * 1024); } while (0)
#define PG8_MMA(ai, bj, At, Bt) do { __builtin_amdgcn_s_setprio(1); _Pragma("unroll") for (int m = 0; m < 4; ++m) _Pragma("unroll") for (int n = 0; n < 2; ++n) { \
        if constexpr (MODE == 1) { acc[ai][bj][m][n] = __builtin_amdgcn_mfma_scale_f32_16x16x128_f8f6f4(cat8(Bt[n][0], Bt[n][1]), cat8(At[m][0], At[m][1]), acc[ai][bj][m][n], 0, 0, 0, 0x7f7f7f7f, 0, 0x7f7f7f7f); } \
        else if constexpr (MODE == 2) { const i32x8 b8_ = cat8(Bt[n][0], Bt[n][1]), a8_ = cat8(At[m][0], At[m][1]); acc[ai][bj][m][n] = __builtin_amdgcn_mfma_scale_f32_16x16x128_f8f6f4(b8_, a8_, acc[ai][bj][m][n], 2, 2, 0, b8_[6], 0, a8_[6]); } \
        else { _Pragma("unroll") for (int k = 0; k < 2; ++k) acc[ai][bj][m][n] = __builtin_amdgcn_mfma_f32_16x16x32_bf16(Bt[n][k], At[m][k], acc[ai][bj][m][n], 0, 0, 0); } } __builtin_amdgcn_s_setprio(0); } while (0)
#define PG8_WAIT_V(n) asm volatile("s_waitcnt vmcnt(" #n ")" ::: "memory")
#define PG8_WAIT_L(n) asm volatile("s_waitcnt lgkmcnt(" #n ")" ::: "memory")
#define PG8_BAR __builtin_amdgcn_s_barrier()
#define PG8_SCHED __builtin_amdgcn_sched_barrier(0)
    Unit cur, nxt; int ui = 0;
    if (!S.next(0, cur)) return;
    f32x4 acc[2][2][4][2];
#pragma unroll
    for (int a = 0; a < 2; ++a)
#pragma unroll
        for (int b = 0; b < 2; ++b)
#pragma unroll
            for (int m = 0; m < 4; ++m)
#pragma unroll
                for (int n = 0; n < 2; ++n) acc[a][b][m][n] = (f32x4){0.f, 0.f, 0.f, 0.f};
    bf16x8 At[4][2], B0[2][2], B1[2][2];
    unsigned cA = (unsigned)cur.pm * tstep, cB = (unsigned)cur.e * (unsigned)g.estride + (unsigned)cur.pn * tstep;
    PG8_STAGE(PG8_SB(0, 0), false, cB, voffB); PG8_STAGE(PG8_SB(0, 1), false, cB + hstep, voffB); PG8_STAGE(PG8_SA(0, 0), true, cA, voffA); PG8_STAGE(PG8_SA(0, 1), true, cA + hstepA, voffA);
    if (wr == 1) PG8_BAR;
    PG8_WAIT_V(2); PG8_BAR;
    PG8_STAGE(PG8_SB(1, 0), false, cB + kstep, voffB); PG8_STAGE(PG8_SA(1, 0), true, cA + kstepA, voffA); PG8_STAGE(PG8_SB(1, 1), false, cB + hstep + kstep, voffB);
    PG8_WAIT_V(6); PG8_BAR;
    for (;;) {
        const bool has_next = S.next(ui + 1, nxt);
        const unsigned nA = has_next ? (unsigned)nxt.pm * tstep : cA, nB = has_next ? (unsigned)nxt.e * (unsigned)g.estride + (unsigned)nxt.pn * tstep : cB;
#pragma unroll 1
        for (int t = 0; t < nt; t += 2) {
            const bool last = (t == nt - 2);
            const unsigned a1 = cA + (unsigned)(t + 1) * kstepA;
            const unsigned a2 = last ? nA : cA + (unsigned)(t + 2) * kstepA, b2 = last ? nB : cB + (unsigned)(t + 2) * kstep;
            const unsigned a3 = a2 + kstepA, b3 = b2 + kstep;
            PG8_LDB(B0, 0, 0); PG8_LDB(B1, 0, 1); PG8_SCHED; PG8_LDA(At, 0, 0); PG8_STAGE(PG8_SA(1, 1), true, a1 + hstepA, voffA);
            PG8_WAIT_V(8); PG8_WAIT_L(0); PG8_BAR; PG8_MMA(0, 0, At, B0); PG8_MMA(0, 1, At, B1); PG8_BAR; PG8_SCHED;
            PG8_LDA(At, 0, 1); PG8_STAGE(PG8_SB(0, 0), false, b2, voffB); PG8_STAGE(PG8_SB(0, 1), false, b2 + hstep, voffB); PG8_STAGE(PG8_SA(0, 0), true, a2, voffA);
            PG8_WAIT_V(8); PG8_WAIT_L(0); PG8_BAR; PG8_MMA(1, 0, At, B0); PG8_MMA(1, 1, At, B1); PG8_BAR; PG8_SCHED;
            PG8_LDB(B0, 1, 0); PG8_LDB(B1, 1, 1); PG8_SCHED; PG8_LDA(At, 1, 0); PG8_STAGE(PG8_SA(0, 1), true, a2 + hstepA, voffA);
            PG8_WAIT_V(8); PG8_WAIT_L(0); PG8_BAR; PG8_MMA(0, 0, At, B0); PG8_MMA(0, 1, At, B1); PG8_BAR; PG8_SCHED;
            PG8_LDA(At, 1, 1); PG8_STAGE(PG8_SB(1, 0), false, b3, voffB); PG8_STAGE(PG8_SB(1, 1), false, b3 + hstep, voffB); PG8_STAGE(PG8_SA(1, 0), true, a3, voffA);
            PG8_WAIT_V(8); PG8_WAIT_L(0); PG8_BAR; PG8_MMA(1, 0, At, B0); PG8_MMA(1, 1, At, B1); PG8_BAR; PG8_SCHED;
        }
        if (wr == 0) PG8_BAR;
        E(acc, cur, wr, wc, fr, fq);
        if (!has_next) break;
#pragma unroll
        for (int a = 0; a < 2; ++a)
#pragma unroll
            for (int b = 0; b < 2; ++b)
#pragma unroll
                for (int m = 0; m < 4; ++m)
#pragma unroll
                    for (int n = 0; n < 2; ++n) acc[a][b][m][n] = (f32x4){0.f, 0.f, 0.f, 0.f};
        cur = nxt; cA = nA; cB = nB; ++ui;
        if (wr == 1) PG8_BAR;
    }
    PG8_WAIT_V(0);
    PG8_BAR;
#undef PG8_SA
#undef PG8_SB
#undef PG8_STAGE
#undef PG8_LDA
#undef PG8_LDB
#undef PG8_MMA
#undef PG8_WAIT_V
#undef PG8_WAIT_L
#undef PG8_BAR
#undef PG8_SCHED
}
}

constexpr int NWAVES = 8, NTHR = 512;
constexpr int NTOK = 32768, SEQ = 8192, DM = 1024, NQKV = 1536, FF = 3584, NE = 8, NHEAD = 16, NKV = 4;
constexpr float LN_EPS = 1e-5f;
constexpr float DN_ALPHA = 1.4142135623730951f;
constexpr float LOG2E = 1.4426950408889634f;
constexpr int MOE_CHUNK_TILES = 264;
constexpr float SX8 = 4.f, SW8 = 128.f, SH8 = 8.f, SD8 = 512.f;
constexpr int MAX_TILES = 264;

constexpr size_t MiB = 1u << 20;
constexpr size_t WS_CTL = 0, CTL_ZERO_BYTES = 1 * MiB;
constexpr size_t WS_COS = 1 * MiB, WS_SIN = 2 * MiB;
constexpr size_t WS_TOPI = 3 * MiB, WS_GATE = WS_TOPI + 256 * 1024, WS_POS = WS_GATE + 256 * 1024, WS_WGCNT = WS_POS + 256 * 1024;
constexpr size_t WS_MWGU = 8 * MiB, WS_MWDN = 64 * MiB;
constexpr size_t WS_WQKV = 92 * MiB, WS_WO = 95 * MiB, WS_WPW1 = 97 * MiB, WS_WPW2 = 101 * MiB, WS_WGU = 103 * MiB, WS_WDN = 117 * MiB;
constexpr size_t WS_ACT = 124 * MiB;
constexpr size_t WS_XB = WS_ACT, WS_QKV = WS_ACT + 64 * MiB, WS_O = WS_ACT + 160 * MiB, WS_X1B = WS_ACT + 224 * MiB, WS_H = WS_ACT;
constexpr size_t WS_X2B = WS_ACT, WS_G1 = WS_ACT + 64 * MiB, WS_C1 = WS_ACT + 128 * MiB, WS_VPW2 = WS_ACT + 192 * MiB;
constexpr size_t WS_XS = 92 * MiB, WS_HC = 158 * MiB, WS_YS = 389 * MiB;
constexpr size_t WS_END = 521 * MiB;
constexpr int X3_STRIDE = 2048;
static_assert(WS_XS + (size_t)MAX_TILES * 256 * DM <= WS_HC && WS_HC + (size_t)MOE_CHUNK_TILES * 256 * FF <= WS_YS && WS_YS + (size_t)MAX_TILES * 256 * DM * 2 <= WS_END, "d_ws map (MoE)");
static_assert(WS_H + (size_t)NTOK * FF * 2 <= WS_X1B && WS_VPW2 + (size_t)NTOK * DM * 2 <= WS_END && WS_WDN + (size_t)DM * FF * 2 <= WS_ACT, "d_ws map");
constexpr int CW_TMO = 0, CW_CODE = 1, CW_BAR = 4096;

constexpr int RING_OFF = 0, RING_BYTES = 131072;
constexpr int LDSCTL_OFF = RING_BYTES, MISC_OFF = LDSCTL_OFF + 320, TAB_OFF = LDSCTL_OFF + 1024;
constexpr int LDS_BYTES = 147456;

#define GAS __attribute__((address_space(1)))
#define LAS __attribute__((address_space(3)))
typedef unsigned short bf16;
typedef unsigned v4u __attribute__((ext_vector_type(4)));
typedef unsigned v2u __attribute__((ext_vector_type(2)));
typedef float f32x4 __attribute__((ext_vector_type(4)));
typedef float f32x16 __attribute__((ext_vector_type(16)));
typedef short bf16x8 __attribute__((ext_vector_type(8)));
typedef short s16x4 __attribute__((ext_vector_type(4)));
typedef float f32x2v __attribute__((ext_vector_type(2)));
typedef GAS unsigned gu32;
#define RLX_AGENT __ATOMIC_RELAXED, __HIP_MEMORY_SCOPE_AGENT
#define LDS_WAIT() asm volatile("s_waitcnt lgkmcnt(0)" ::: "memory")
#define VM_WAIT() asm volatile("s_waitcnt vmcnt(0)" ::: "memory")
__device__ __forceinline__ unsigned pk2(float lo, float hi) { return pg8::cvt_pk_bf16(lo, hi); }
__device__ __forceinline__ float bf_lo(unsigned w) { return __uint_as_float(w << 16); }
__device__ __forceinline__ float bf_hi(unsigned w) { return __uint_as_float(w & 0xffff0000u); }

#define XB_TMO      128
#define XB_XCNT(j)  (256  + 64 * (j))
#define XB_XSUB(j)  (1280 + 64 * (j))
#define XB_XGEN(j)  (2304 + 64 * (j))
#define XB_TOP      3328
#define XB_TOPGEN   3392
#define XCD_BAR_WORDS 3456
#define XB_SPIN_CAP (1u << 18)
__device__ __forceinline__ unsigned xb_ld(unsigned* p)              { return __hip_atomic_load(p, __ATOMIC_RELAXED, __HIP_MEMORY_SCOPE_AGENT); }
__device__ __forceinline__ unsigned xb_add(unsigned* p, unsigned v) { return __hip_atomic_fetch_add(p, v, __ATOMIC_RELAXED, __HIP_MEMORY_SCOPE_AGENT); }
__device__ __forceinline__ unsigned xb_xcc_id() { return (unsigned)__builtin_amdgcn_s_getreg((3 << 11) | 20) & 0xFu; }
#define XB_SPIN(cond, bar) do { unsigned _sp = 0; while (cond) { __builtin_amdgcn_s_sleep(1); \
    if ((++_sp & 255u) == 0u) { if (xb_ld(&(bar)[XB_TMO])) break; if (_sp > XB_SPIN_CAP) { atomicAdd(&(bar)[XB_TMO], 1u); break; } } } } while (0)
struct XcdBarrier { unsigned* bar; unsigned x; volatile LAS unsigned* st; };
__device__ __forceinline__ XcdBarrier xcd_barrier_post(unsigned* bar, volatile LAS unsigned* st) {
    XcdBarrier b; b.bar = bar; b.x = xb_xcc_id(); b.st = st;
    if (threadIdx.x == 0) (void)xb_add(&bar[XB_XCNT(b.x)], 1u);
    return b;
}
__device__ __forceinline__ void xcd_barrier_complete(unsigned* bar, unsigned x, unsigned& nloc, unsigned& nx) {
    const unsigned G = gridDim.x * gridDim.y * gridDim.z;
    unsigned sum, cnt, mine, sp = 0u;
    for (;;) {
        sum = 0u; cnt = 0u; mine = 0u;
#pragma unroll
        for (unsigned j = 0; j < 16; ++j) { const unsigned c = xb_ld(&bar[XB_XCNT(j)]); sum += c; cnt += (c > 0u) ? 1u : 0u; mine = (j == x) ? c : mine; }
        if (sum == G) break;
        __builtin_amdgcn_s_sleep(1);
        if ((++sp & 255u) == 0u) { if (xb_ld(&bar[XB_TMO])) break; if (sp > XB_SPIN_CAP) { atomicAdd(&bar[XB_TMO], 1u); break; } }
    }
    nloc = mine > 0u ? mine : 1u; nx = cnt > 0u ? cnt : 1u;
}
__device__ __forceinline__ void xcd_barrier(const XcdBarrier& b) {
    asm volatile("s_waitcnt vmcnt(0)" ::: "memory");
    __syncthreads();
    if (threadIdx.x == 0) {
        unsigned* bar = b.bar;
        __builtin_amdgcn_s_waitcnt(0);
        unsigned nloc = b.st[0], nx = b.st[1];
        if (nloc == 0u) { xcd_barrier_complete(bar, b.x, nloc, nx); b.st[0] = nloc; b.st[1] = nx; }
        const unsigned old = xb_add(&bar[XB_XSUB(b.x)], 1u);
        const unsigned gen = old / nloc;
        if (old + 1u == (gen + 1u) * nloc) {
            __builtin_amdgcn_fence(__ATOMIC_RELEASE, "agent");
            asm volatile("s_waitcnt vmcnt(0)" ::: "memory");
            const unsigned og = xb_add(&bar[XB_TOP], 1u);
            const unsigned tg = og / nx;
            if (og + 1u == (tg + 1u) * nx) xb_add(&bar[XB_TOPGEN], 1u);
            else XB_SPIN(xb_ld(&bar[XB_TOPGEN]) == tg, bar);
            __builtin_amdgcn_fence(__ATOMIC_ACQUIRE, "agent");
            xb_add(&bar[XB_XGEN(b.x)], 1u);
            asm volatile("s_waitcnt vmcnt(0)" ::: "memory");
        } else {
            XB_SPIN(xb_ld(&bar[XB_XGEN(b.x)]) == gen, bar);
            __builtin_amdgcn_fence(__ATOMIC_ACQUIRE, "agent");
            asm volatile("s_waitcnt vmcnt(0)" ::: "memory");
        }
    }
    __syncthreads();
}

__device__ __forceinline__ float wave_sum(float v) {
#pragma unroll
    for (int o = 1; o < 64; o <<= 1) v += __shfl_xor(v, o);
    return v;
}

struct Ptrs {
    const float* in[23]; float* out; unsigned char* ws;
};

__device__ __forceinline__ int map_row(int kind, int n) {
    if (kind == 1) { if (n >= 1280) return n; const int d = n & 63; return (n & ~63) + 8 * ((d & 31) >> 2) + 4 * (d >> 5) + (d & 3); }
    if (kind == 2) return 8 * (n >> 2) + (n & 3);
    if (kind == 3) return 8 * (n >> 2) + 4 + (n & 3);
    if (kind == 4) { const int f = n & 1023; return 8 * (f >> 2) + 4 * (n >> 10) + (f & 3); }
    return n;
}
__device__ __forceinline__ void tr_item(const float* W, int N, int K, int k0, int n0, bf16* dst, int kind, LAS unsigned char* scr, int lane) {
    f32x4 v[16];
    const int c4 = lane & 15, kr = lane >> 4;
#pragma unroll
    for (int j = 0; j < 16; ++j) v[j] = *(const GAS f32x4*)(W + (size_t)(k0 + kr + 4 * j) * N + n0 + 4 * c4);
#pragma unroll
    for (int j = 0; j < 16; ++j) { v2u w; w.x = pk2(v[j][0], v[j][1]); w.y = pk2(v[j][2], v[j][3]); *(LAS v2u*)(scr + (kr + 4 * j) * 136 + c4 * 8) = w; }
    LDS_WAIT(); asm volatile("" ::: "memory");
    const int c = lane & 7;
#pragma unroll
    for (int j = 0; j < 8; ++j) {
        const int n = 8 * j + (lane >> 3); const LAS unsigned char* s = scr + (8 * c) * 136 + 2 * n;
        unsigned h[8];
#pragma unroll
        for (int i = 0; i < 8; ++i) h[i] = *(const LAS unsigned short*)(s + i * 136);
        v4u o; o.x = h[0] | (h[1] << 16); o.y = h[2] | (h[3] << 16); o.z = h[4] | (h[5] << 16); o.w = h[6] | (h[7] << 16);
        pg8::st16(dst + (size_t)map_row(kind, n0 + n) * K + k0 + 8 * c, o);
    }
    LDS_WAIT(); asm volatile("" ::: "memory");
}
__device__ __forceinline__ int map_row8(int which, int f) { return 256 * (f >> 7) + 128 * ((f >> 2) & 1) + 32 * ((f & 127) >> 5) + 8 * ((f >> 3) & 3) + 4 * which + (f & 3); }
__device__ __forceinline__ void tr_item8(const float* W, int N, int K, int k0, int n0, unsigned char* dst, int which, float scale, LAS unsigned char* scr, int lane) {
    f32x4 v[16];
    const int c4 = lane & 15, kr = lane >> 4;
#pragma unroll
    for (int j = 0; j < 16; ++j) v[j] = *(const GAS f32x4*)(W + (size_t)(k0 + kr + 4 * j) * N + n0 + 4 * c4);
#pragma unroll
    for (int j = 0; j < 16; ++j) *(LAS unsigned*)(scr + (kr + 4 * j) * 68 + c4 * 4) = pg8::pk4_fp8(v[j][0] * scale, v[j][1] * scale, v[j][2] * scale, v[j][3] * scale);
    LDS_WAIT(); asm volatile("" ::: "memory");
    const int c = lane & 3;
#pragma unroll
    for (int j = 0; j < 4; ++j) {
        const int n = 16 * j + (lane >> 2); const LAS unsigned char* sp = scr + (16 * c) * 68 + n;
        unsigned h[16];
#pragma unroll
        for (int i = 0; i < 16; ++i) h[i] = *(const LAS unsigned char*)(sp + i * 68);
        v4u o;
        o.x = h[0] | (h[1] << 8) | (h[2] << 16) | (h[3] << 24); o.y = h[4] | (h[5] << 8) | (h[6] << 16) | (h[7] << 24);
        o.z = h[8] | (h[9] << 8) | (h[10] << 16) | (h[11] << 24); o.w = h[12] | (h[13] << 8) | (h[14] << 16) | (h[15] << 24);
        const int drow = which < 0 ? (n0 + n) : map_row8(which, n0 + n);
        pg8::st16(dst + (size_t)drow * K + k0 + 16 * c, o);
    }
    LDS_WAIT(); asm volatile("" ::: "memory");
}
__device__ __forceinline__ void tr_item6(const float* W, int N, int K, int k0, int n0, unsigned char* dst, int which, LAS unsigned char* scr, int lane) {
    LAS float* sf = (LAS float*)scr;
    { const int c4 = lane & 7, kr = lane >> 3;
#pragma unroll
      for (int j = 0; j < 16; ++j) { const f32x4 v = *(const GAS f32x4*)(W + (size_t)(k0 + kr + 8 * j) * N + n0 + 4 * c4); *(LAS f32x4*)(sf + (kr + 8 * j) * 32 + 4 * c4) = v; } }
    LDS_WAIT(); asm volatile("" ::: "memory");
    const int n = lane & 31, half = lane >> 5;
    unsigned char* drow = dst + (size_t)map_row8(which, n0 + n) * K + k0;
#pragma unroll
    for (int blk = 0; blk < 2; ++blk) {
        const int kb = 64 * half + 32 * blk, g = 2 * half + blk;
        pg8::f32x16 a, b;
#pragma unroll
        for (int i = 0; i < 16; ++i) { a[i] = sf[(kb + i) * 32 + n]; b[i] = sf[(kb + 16 + i) * 32 + n]; }
        pg8::u32x4 c0, c1; pg8::cvt_block6(a, b, c0, c1);
        pg8::st16(drow + 16 * g, c0); pg8::st16(drow + 64 + 16 * g, c1);
    }
    LDS_WAIT(); asm volatile("" ::: "memory");
}
__device__ __forceinline__ void p0_prologue(const Ptrs& P, LAS unsigned char* lds, int vcu, int G, int tid, int lane, int wave) {
    unsigned char* ws = P.ws;
    LAS unsigned char* scr = lds + RING_OFF + wave * 16384;
    const int gw = vcu * NWAVES + wave, NGW = G * NWAVES;
    constexpr int I_QKV = 16 * 24, I_WO = 16 * 16, I_PW1 = 16 * 32, I_PW2 = 16 * 16, I_G = 16 * 56, I_DN = 56 * 16;
    constexpr int B0 = 0, B1 = B0 + I_QKV, B2 = B1 + I_WO, B3 = B2 + I_PW1, B4 = B3 + I_PW2, B5 = B4 + I_G, B6 = B5 + I_G, B7 = B6 + I_DN, B8 = B7 + 8 * I_G, B9 = B8 + 8 * I_G, B10 = B9 + 8 * I_DN;
    for (int it = gw; it < B10; it += NGW) {
        const float* W; int N, K, kind, r; bf16* dst;
        if (it < B1)      { r = it - B0; W = P.in[1];  K = 1024; N = 1536; kind = 1; dst = (bf16*)(ws + WS_WQKV); }
        else if (it < B2) { r = it - B1; W = P.in[3];  K = 1024; N = 1024; kind = 0; dst = (bf16*)(ws + WS_WO); }
        else if (it < B3) { r = it - B2; W = P.in[4];  K = 1024; N = 2048; kind = 4; dst = (bf16*)(ws + WS_WPW1); }
        else if (it < B4) { r = it - B3; W = P.in[10]; K = 1024; N = 1024; kind = 0; dst = (bf16*)(ws + WS_WPW2); }
        else if (it < B5) { r = it - B4; W = P.in[12]; K = 1024; N = 3584; kind = 2; dst = (bf16*)(ws + WS_WGU); }
        else if (it < B6) { r = it - B5; W = P.in[13]; K = 1024; N = 3584; kind = 3; dst = (bf16*)(ws + WS_WGU); }
        else if (it < B7) { r = it - B6; W = P.in[14]; K = 3584; N = 1024; kind = 0; dst = (bf16*)(ws + WS_WDN); }
        else {
            const float* W8; int N8, K8, which; float sc; unsigned char* d8;
            if (it < B9) {
                const int wh = it < B8 ? 0 : 1; r = it - (wh ? B8 : B7); const int e = r / I_G; r -= e * I_G; const int kb6 = r / 112, nb6 = r - kb6 * 112;
                tr_item6(P.in[16 + wh] + (size_t)e * 1024 * 3584, 3584, 1024, kb6 * 128, nb6 * 32, ws + WS_MWGU + (size_t)e * 7168 * 1024, wh, scr, lane); continue; }
            { r = it - B9; const int e = r / I_DN; r -= e * I_DN; W8 = P.in[18] + (size_t)e * 3584 * 1024; K8 = 3584; N8 = 1024; which = -1; sc = SD8; d8 = ws + WS_MWDN + (size_t)e * 1024 * 3584; }
            const int nblk8 = N8 / 64, kb8 = r / nblk8, nb8 = r - kb8 * nblk8;
            tr_item8(W8, N8, K8, kb8 * 64, nb8 * 64, d8, which, sc, scr, lane);
            continue;
        }
        const int nblk = N / 64, kb = r / nblk, nb = r - kb * nblk;
        tr_item(W, N, K, kb * 64, nb * 64, dst, kind, scr, lane);
    }
    {
        const size_t nvec = (size_t)NTOK * DM / 8; const GAS f32x4* x4 = (const GAS f32x4*)P.in[0]; GAS v4u* o = (GAS v4u*)(ws + WS_XB);
        for (size_t i = (size_t)vcu * NTHR + tid; i < nvec; i += (size_t)G * NTHR) { const f32x4 a = x4[2 * i], b = x4[2 * i + 1];
            v4u w; w.x = pk2(a[0], a[1]); w.y = pk2(a[2], a[3]); w.z = pk2(b[0], b[1]); w.w = pk2(b[2], b[3]); pg8::st16((void*)(o + i), w); }
    }
    {
        float* ct = (float*)(ws + WS_COS); float* st = (float*)(ws + WS_SIN);
        for (int i = vcu * NTHR + tid; i < SEQ * 32; i += G * NTHR) { const int pos = i >> 5, j = i & 31;
            const float inv = (float)pow(10000.0, -(double)j / 32.0); const float ang = (float)pos * inv;
            ct[i] = (float)cos((double)ang); st[i] = (float)sin((double)ang); }
    }
}

__device__ __forceinline__ int crow(int r, int hi) { return (r & 3) + 8 * (r >> 2) + 4 * hi; }
__device__ __forceinline__ void attn_phase(const Ptrs& P, LAS unsigned char* lds, int G, int tid, int lane, int wave) {
    constexpr int KS_STRIDE = 144, VT_STRIDE = 784, VT_OFF = 384 * KS_STRIDE;
    const bf16* qkv = (const bf16*)(P.ws + WS_QKV); bf16* O = (bf16*)(P.ws + WS_O); const float* sink = P.in[2];
    LAS unsigned char* Ks = lds + RING_OFF; LAS unsigned char* Vt = lds + RING_OFF + VT_OFF;
    const int r32 = lane & 31, hi = lane >> 5, g = wave >> 1, qhalf = wave & 1;
    for (int u = blockIdx.x; u < 4 * 64 * 4; u += G) {
        const int kvh = u & 3, blk = (u >> 2) & 63, b = u >> 8;
#pragma unroll
        for (int j = 0; j < 6; ++j) {
            const int id = tid + NTHR * j, row = id >> 3, pc = id & 7, kpos = (blk - 1) * 128 + row;
            v4u kv = (v4u){0u, 0u, 0u, 0u}, vv = (v4u){0u, 0u, 0u, 0u};
            if (kpos >= 0 && kpos < SEQ) { const bf16* src = qkv + (size_t)(b * SEQ + kpos) * NQKV + kvh * 64 + pc * 8; kv = *(const GAS v4u*)(src + 1024); vv = *(const GAS v4u*)(src + 1280); }
            *(LAS v4u*)(Ks + row * KS_STRIDE + pc * 16) = kv;
#pragma unroll
            for (int e = 0; e < 8; ++e) *(LAS unsigned short*)(Vt + (pc * 8 + e) * VT_STRIDE + row * 2) = (unsigned short)((vv[e >> 1] >> (16 * (e & 1))) & 0xffffu);
        }
        __syncthreads();
        const int head = kvh * 4 + g; const float sink_l2 = sink[head] * LOG2E;
#pragma unroll 1
        for (int qg = 0; qg < 2; ++qg) {
            const int ql0 = 64 * qhalf + 32 * qg, jt0 = 2 * qhalf + qg;
            const size_t tok = (size_t)b * SEQ + blk * 128 + ql0 + r32;
            bf16x8 qf[4];
#pragma unroll
            for (int s = 0; s < 4; ++s) qf[s] = *(const GAS bf16x8*)(qkv + tok * NQKV + head * 64 + 16 * s + 8 * hi);
            float m = sink_l2, l = (hi == 0) ? 1.f : 0.f;
            f32x16 o0 = {}, o1 = {};
#pragma unroll
            for (int c = 0; c < 3; ++c) {
                f32x16 S[3];
#pragma unroll
                for (int tt = 0; tt < 3; ++tt) {
                    const int jt = jt0 + 3 * c + tt;
                    const LAS unsigned char* kp = Ks + (32 * jt + r32) * KS_STRIDE + 16 * hi;
                    f32x16 a = {};
#pragma unroll
                    for (int s = 0; s < 4; ++s) { const bf16x8 kf = *(const LAS bf16x8*)(kp + 32 * s); a = __builtin_amdgcn_mfma_f32_32x32x16_bf16(kf, qf[s], a, 0, 0, 0); }
                    const int tau = 3 * c + tt, kpos0 = (blk - 1) * 128 + 32 * jt;
                    const bool tile_ok = (kpos0 >= 0) && (kpos0 < SEQ);
#pragma unroll
                    for (int r = 0; r < 16; ++r) { const int kk = crow(r, hi); bool ok = tile_ok; if (tau == 0) ok = ok && (kk >= r32); if (tau == 8) ok = ok && (kk <= r32); a[r] = ok ? a[r] : -INFINITY; }
                    S[tt] = a;
                }
                float cm = -INFINITY;
#pragma unroll
                for (int tt = 0; tt < 3; ++tt)
#pragma unroll
                    for (int r = 0; r < 16; ++r) cm = fmaxf(cm, S[tt][r]);
                cm = fmaxf(cm, __shfl_xor(cm, 32));
                if (__any(cm > m + 8.f)) { const float mn = fmaxf(m, cm); const float f = __builtin_amdgcn_exp2f(m - mn); l *= f; o0 *= f; o1 *= f; m = mn; }
                float ls = 0.f;
#pragma unroll
                for (int tt = 0; tt < 3; ++tt)
#pragma unroll
                    for (int r = 0; r < 16; ++r) { const float p = __builtin_amdgcn_exp2f(S[tt][r] - m); S[tt][r] = p; ls += p; }
                l += ls;
#pragma unroll
                for (int tt = 0; tt < 3; ++tt) {
                    const int jt = jt0 + 3 * c + tt;
#pragma unroll
                    for (int ks = 0; ks < 2; ++ks) {
                        v4u pw; pw.x = pk2(S[tt][8 * ks + 0], S[tt][8 * ks + 1]); pw.y = pk2(S[tt][8 * ks + 2], S[tt][8 * ks + 3]); pw.z = pk2(S[tt][8 * ks + 4], S[tt][8 * ks + 5]); pw.w = pk2(S[tt][8 * ks + 6], S[tt][8 * ks + 7]);
                        const bf16x8 pf = __builtin_bit_cast(bf16x8, pw);
                        const LAS unsigned char* vp = Vt + r32 * VT_STRIDE + (32 * jt + 16 * ks + 4 * hi) * 2;
                        { const v2u lo = *(const LAS v2u*)(vp), hi2 = *(const LAS v2u*)(vp + 16); const v4u vw = (v4u){lo.x, lo.y, hi2.x, hi2.y};
                          o0 = __builtin_amdgcn_mfma_f32_32x32x16_bf16(__builtin_bit_cast(bf16x8, vw), pf, o0, 0, 0, 0); }
                        { const v2u lo = *(const LAS v2u*)(vp + 32 * VT_STRIDE), hi2 = *(const LAS v2u*)(vp + 32 * VT_STRIDE + 16); const v4u vw = (v4u){lo.x, lo.y, hi2.x, hi2.y};
                          o1 = __builtin_amdgcn_mfma_f32_32x32x16_bf16(__builtin_bit_cast(bf16x8, vw), pf, o1, 0, 0, 0); }
                    }
                }
            }
            l += __shfl_xor(l, 32);
            const float inv = 1.f / l;
            bf16* op = O + tok * DM + head * 64 + 4 * hi;
#pragma unroll
            for (int r4 = 0; r4 < 4; ++r4) {
                v2u w; w.x = pk2(o0[4 * r4] * inv, o0[4 * r4 + 1] * inv); w.y = pk2(o0[4 * r4 + 2] * inv, o0[4 * r4 + 3] * inv); pg8::st8(op + 8 * r4, w);
                v2u w1; w1.x = pk2(o1[4 * r4] * inv, o1[4 * r4 + 1] * inv); w1.y = pk2(o1[4 * r4 + 2] * inv, o1[4 * r4 + 3] * inv); pg8::st8(op + 32 + 8 * r4, w1);
            }
        }
        __syncthreads();
    }
}

struct Row16 { float v[16]; };
__device__ __forceinline__ void ln_row(Row16& x, const Row16& gm, const Row16& bt) {
    float s = 0.f;
#pragma unroll
    for (int i = 0; i < 16; ++i) s += x.v[i];
    const float mean = wave_sum(s) * (1.f / DM); float q = 0.f;
#pragma unroll
    for (int i = 0; i < 16; ++i) { x.v[i] -= mean; q += x.v[i] * x.v[i]; }
    const float rstd = 1.0f / sqrtf(wave_sum(q) * (1.f / DM) + LN_EPS);
#pragma unroll
    for (int i = 0; i < 16; ++i) x.v[i] = x.v[i] * rstd * gm.v[i] + bt.v[i];
}
__device__ __forceinline__ void load_vec16(Row16& r, const float* p, int lane) {
#pragma unroll
    for (int j = 0; j < 2; ++j) { const f32x4 a = *(const GAS f32x4*)(p + 8 * lane + 512 * j), b = *(const GAS f32x4*)(p + 8 * lane + 512 * j + 4);
#pragma unroll
        for (int i = 0; i < 4; ++i) { r.v[8 * j + i] = a[i]; r.v[8 * j + 4 + i] = b[i]; } }
}
__device__ __forceinline__ void load_bf16row(Row16& r, const bf16* p, int lane) {
#pragma unroll
    for (int j = 0; j < 2; ++j) { const v4u w = *(const GAS v4u*)(p + 8 * lane + 512 * j);
        r.v[8 * j + 0] = bf_lo(w.x); r.v[8 * j + 1] = bf_hi(w.x); r.v[8 * j + 2] = bf_lo(w.y); r.v[8 * j + 3] = bf_hi(w.y);
        r.v[8 * j + 4] = bf_lo(w.z); r.v[8 * j + 5] = bf_hi(w.z); r.v[8 * j + 6] = bf_lo(w.w); r.v[8 * j + 7] = bf_hi(w.w); }
}
__device__ __forceinline__ void store_bf16row(const Row16& r, bf16* p, int lane) {
#pragma unroll
    for (int j = 0; j < 2; ++j) { v4u w; w.x = pk2(r.v[8 * j], r.v[8 * j + 1]); w.y = pk2(r.v[8 * j + 2], r.v[8 * j + 3]); w.z = pk2(r.v[8 * j + 4], r.v[8 * j + 5]); w.w = pk2(r.v[8 * j + 6], r.v[8 * j + 7]);
        pg8::st16(p + 8 * lane + 512 * j, w); }
}
__device__ __forceinline__ void ln_phase(const bf16* src, const float* g, const float* bta, bf16* dst, int vcu, int G, int lane, int wave) {
    Row16 gm, bt; load_vec16(gm, g, lane); load_vec16(bt, bta, lane);
    const int stride = G * NWAVES;
    for (int row0 = vcu * NWAVES + wave; row0 < NTOK; row0 += 4 * stride) {
        Row16 x[4];
#pragma unroll
        for (int j = 0; j < 4; ++j) { const int row = row0 + j * stride; if (row < NTOK) load_bf16row(x[j], src + (size_t)row * DM, lane); }
#pragma unroll
        for (int j = 0; j < 4; ++j) { const int row = row0 + j * stride; if (row < NTOK) { ln_row(x[j], gm, bt); store_bf16row(x[j], dst + (size_t)row * DM, lane); } }
    }
}
__device__ __forceinline__ void ln_router_phase(const Ptrs& P, LAS unsigned char* lds, const bf16* src, const float* g, const float* bta, bf16* dst, int G, int tid, int lane, int wave) {
    const float* router = P.in[15]; int* topi = (int*)(P.ws + WS_TOPI); float* gate = (float*)(P.ws + WS_GATE); int* wgcnt = (int*)(P.ws + WS_WGCNT);
    LAS int* hist = (LAS int*)(lds + RING_OFF);
    if (tid < 8) hist[tid] = 0;
    __syncthreads();
    const int tpw = (NTOK + G - 1) / G, t0 = blockIdx.x * tpw, t1 = (t0 + tpw < NTOK) ? t0 + tpw : NTOK;
    {
        Row16 gm, bt; load_vec16(gm, g, lane); load_vec16(bt, bta, lane);
        f32x4 rwa[16], rwb[16];
#pragma unroll
        for (int j = 0; j < 2; ++j)
#pragma unroll
            for (int i = 0; i < 8; ++i) { const float* rp = router + (size_t)(8 * lane + 512 * j + i) * 8; rwa[8 * j + i] = *(const GAS f32x4*)rp; rwb[8 * j + i] = *(const GAS f32x4*)(rp + 4); }
        int cnt[8];
#pragma unroll
        for (int e = 0; e < 8; ++e) cnt[e] = 0;
        Row16 xnext; if (t0 + wave < t1) load_bf16row(xnext, src + (size_t)(t0 + wave) * DM, lane);
        for (int row = t0 + wave; row < t1; row += NWAVES) {
            Row16 x = xnext; if (row + NWAVES < t1) load_bf16row(xnext, src + (size_t)(row + NWAVES) * DM, lane);
            ln_row(x, gm, bt);
            store_bf16row(x, dst + (size_t)row * X3_STRIDE, lane);
            float lg[8];
#pragma unroll
            for (int e = 0; e < 8; ++e) lg[e] = 0.f;
#pragma unroll
            for (int i = 0; i < 16; ++i) { const float xv = x.v[i]; const f32x4 a = rwa[i], b2 = rwb[i];
                lg[0] += xv * a[0]; lg[1] += xv * a[1]; lg[2] += xv * a[2]; lg[3] += xv * a[3]; lg[4] += xv * b2[0]; lg[5] += xv * b2[1]; lg[6] += xv * b2[2]; lg[7] += xv * b2[3]; }
#pragma unroll
            for (int e = 0; e < 8; ++e) lg[e] = wave_sum(lg[e]);
            int i1 = 0; float v1 = lg[0];
#pragma unroll
            for (int e = 1; e < 8; ++e) if (lg[e] > v1) { v1 = lg[e]; i1 = e; }
            int i2 = -1; float v2 = -INFINITY;
#pragma unroll
            for (int e = 0; e < 8; ++e) if (e != i1 && lg[e] > v2) { v2 = lg[e]; i2 = e; }
            const float e2 = expf(v2 - v1), g1 = 1.f / (1.f + e2), g2 = e2 / (1.f + e2);
            if (lane == 0) { topi[2 * row] = i1; topi[2 * row + 1] = i2; gate[2 * row] = g1; gate[2 * row + 1] = g2; }
#pragma unroll
            for (int e = 0; e < 8; ++e) cnt[e] += (i1 == e || i2 == e) ? 1 : 0;
        }
        if (lane == 0) {
#pragma unroll
            for (int e = 0; e < 8; ++e) atomicAdd((int*)(hist + e), cnt[e]);
        }
    }
    __syncthreads();
    if (tid < 8) wgcnt[blockIdx.x * 8 + tid] = hist[tid];
    __syncthreads();
}
__device__ __forceinline__ void route_phase(const Ptrs& P, LAS unsigned char* lds, int G, int tid, int lane, int wave) {
    const int* topi = (const int*)(P.ws + WS_TOPI); const int* wgcnt = (const int*)(P.ws + WS_WGCNT); int* posof = (int*)(P.ws + WS_POS);
    const bf16* x3 = (const bf16*)P.out; unsigned char* xs = P.ws + WS_XS;
    LAS int* tot = (LAS int*)(lds + RING_OFF); LAS int* bef = tot + 8; LAS int* base = tot + 16; LAS int* posl = tot + 64;
    LAS int* ts = (LAS int*)(lds + TAB_OFF);
    if (tid < 16) tot[tid] = 0;
    __syncthreads();
    { const int e = tid & 7; int a = 0, bsum = 0;
      for (int w = tid >> 3; w < G; w += NTHR / 8) { const int c = wgcnt[w * 8 + e]; a += c; if (w < (int)blockIdx.x) bsum += c; }
      atomicAdd((int*)(tot + e), a); atomicAdd((int*)(bef + e), bsum); }
    __syncthreads();
    if (tid == 0) { int t = 0;
        for (int e = 0; e < 8; ++e) { ts[e] = t; base[e] = t * 256 + bef[e]; t += (tot[e] + 255) >> 8; }
        ts[8] = t; }
    __syncthreads();
    const int tpw = (NTOK + G - 1) / G, t0 = blockIdx.x * tpw, t1 = (t0 + tpw < NTOK) ? t0 + tpw : NTOK, nq = 2 * (t1 - t0);
    if (wave == 0) {
        int bs[8];
#pragma unroll
        for (int e = 0; e < 8; ++e) bs[e] = base[e];
        for (int q0 = 0; q0 < nq; q0 += 64) {
            const int q = q0 + lane; const int myE = (q < nq) ? topi[2 * t0 + q] : -1; int pos = 0;
#pragma unroll
            for (int e = 0; e < 8; ++e) { const unsigned long long bal = __ballot(myE == e); const int below = __builtin_popcountll(bal & ((1ull << lane) - 1ull));
                if (myE == e) pos = bs[e] + below; bs[e] += __builtin_popcountll(bal); }
            if (q < nq) { posl[q] = pos; posof[2 * t0 + q] = pos; }
        }
    }
    __syncthreads();
    for (int q0 = 2 * wave; q0 < nq; q0 += 2 * NWAVES) {
        const int q = q0 + (lane >> 5), b = lane & 31;
        if (q < nq) { const int pos = posl[q]; const bf16* sp = x3 + (size_t)(t0 + (q >> 1)) * X3_STRIDE + 32 * b;
            v4u w[4];
#pragma unroll
            for (int i = 0; i < 4; ++i) w[i] = *(const GAS v4u*)(sp + 8 * i);
            pg8::f32x16 fa, fb;
#pragma unroll
            for (int i = 0; i < 2; ++i) { fa[8 * i + 0] = bf_lo(w[i].x); fa[8 * i + 1] = bf_hi(w[i].x); fa[8 * i + 2] = bf_lo(w[i].y); fa[8 * i + 3] = bf_hi(w[i].y); fa[8 * i + 4] = bf_lo(w[i].z); fa[8 * i + 5] = bf_hi(w[i].z); fa[8 * i + 6] = bf_lo(w[i].w); fa[8 * i + 7] = bf_hi(w[i].w);
                fb[8 * i + 0] = bf_lo(w[2 + i].x); fb[8 * i + 1] = bf_hi(w[2 + i].x); fb[8 * i + 2] = bf_lo(w[2 + i].y); fb[8 * i + 3] = bf_hi(w[2 + i].y); fb[8 * i + 4] = bf_lo(w[2 + i].z); fb[8 * i + 5] = bf_hi(w[2 + i].z); fb[8 * i + 6] = bf_lo(w[2 + i].w); fb[8 * i + 7] = bf_hi(w[2 + i].w); }
            pg8::u32x4 c0, c1; pg8::cvt_block6(fa, fb, c0, c1);
            unsigned char* d = xs + (size_t)pos * DM + 128 * (b >> 2) + 16 * (b & 3);
            pg8::st16(d, c0); pg8::st16(d + 64, c1); }
    }
    if (blockIdx.x < 8) { const int e = blockIdx.x; const int r0 = ts[e] * 256 + tot[e], r1 = ts[e + 1] * 256;
        for (int r = r0 + wave; r < r1; r += NWAVES) *(GAS v4u*)(xs + (size_t)r * DM + 16 * lane) = (v4u){0u, 0u, 0u, 0u}; }
    __syncthreads();
}
__device__ __forceinline__ void combine_phase(const Ptrs& P, const float* g, const float* bta, int vcu, int G, int lane, int wave) {
    const bf16* x3 = (const bf16*)P.out; const bf16* ys = (const bf16*)(P.ws + WS_YS); const int* posof = (const int*)(P.ws + WS_POS); const float* gate = (const float*)(P.ws + WS_GATE);
    Row16 gm, bt; load_vec16(gm, g, lane); load_vec16(bt, bta, lane);
    const int stride = G * NWAVES;
    for (int row0 = vcu * NWAVES + wave; row0 < NTOK; row0 += 2 * stride) {
        Row16 x[2], y1[2], y2[2]; float g1[2], g2[2];
#pragma unroll
        for (int j = 0; j < 2; ++j) { const int row = row0 + j * stride; if (row < NTOK) {
            const int p1 = posof[2 * row], p2 = posof[2 * row + 1]; g1[j] = gate[2 * row]; g2[j] = gate[2 * row + 1];
            load_bf16row(x[j], x3 + (size_t)row * X3_STRIDE, lane); load_bf16row(y1[j], ys + (size_t)p1 * DM, lane); load_bf16row(y2[j], ys + (size_t)p2 * DM, lane); } }
#pragma unroll
        for (int j = 0; j < 2; ++j) { const int row = row0 + j * stride; if (row < NTOK) {
#pragma unroll
            for (int i = 0; i < 16; ++i) x[j].v[i] = DN_ALPHA * x[j].v[i] + (g1[j] * y1[j].v[i] + g2[j] * y2[j].v[i]);
            ln_row(x[j], gm, bt);
            float* o = P.out + (size_t)row * DM;
#pragma unroll
            for (int jj = 0; jj < 2; ++jj) { *(GAS f32x4*)(o + 8 * lane + 512 * jj) = (f32x4){x[j].v[8 * jj], x[j].v[8 * jj + 1], x[j].v[8 * jj + 2], x[j].v[8 * jj + 3]}; *(GAS f32x4*)(o + 8 * lane + 512 * jj + 4) = (f32x4){x[j].v[8 * jj + 4], x[j].v[8 * jj + 5], x[j].v[8 * jj + 6], x[j].v[8 * jj + 7]}; }
        } }
    }
}

__device__ __forceinline__ void conv_phase(const Ptrs& P, LAS unsigned char* lds, int G, int tid, int lane, int wave) {
    const bf16* gin = (const bf16*)(P.ws + WS_G1); bf16* cout = (bf16*)(P.ws + WS_C1);
    const float* dw = P.in[6]; const float* dwb = P.in[7]; const float* ng = P.in[8]; const float* nb = P.in[9];
    LAS float* wl = (LAS float*)(lds + RING_OFF);
    LAS float* red = (LAS float*)(lds + RING_OFF + 31 * 1024 * 4);
    for (int i = tid; i < 31 * 256; i += NTHR) ((LAS f32x4*)wl)[i] = ((const GAS f32x4*)dw)[i];
    __syncthreads();
    const int tg = wave >> 2, c0 = 4 * ((wave & 3) * 64 + lane);
    const f32x4 bias = *(const GAS f32x4*)(dwb + c0);
    for (int tile = blockIdx.x; tile < NTOK / 16; tile += G) {
        const int tok0 = tile * 16 + 8 * tg, s0 = (tok0 & (SEQ - 1)) - 15;
        f32x4 acc[8], W[8];
#pragma unroll
        for (int o = 0; o < 8; ++o) { acc[o] = bias; W[o] = (f32x4){0.f, 0.f, 0.f, 0.f}; }
        v2u xn[8];
#pragma unroll
        for (int j = 0; j < 8; ++j) { const int sq = s0 + j; xn[j] = (v2u){0u, 0u}; if (sq >= 0 && sq < SEQ) xn[j] = *(const GAS v2u*)(gin + (size_t)(tok0 - 15 + j) * DM + c0); }
#pragma unroll 1
        for (int ib = 0; ib < 40; ib += 8) {
            v2u xc[8];
#pragma unroll
            for (int j = 0; j < 8; ++j) xc[j] = xn[j];
#pragma unroll
            for (int j = 0; j < 8; ++j) { const int i = ib + 8 + j, sq = s0 + i; xn[j] = (v2u){0u, 0u}; if (i < 38 && sq >= 0 && sq < SEQ) xn[j] = *(const GAS v2u*)(gin + (size_t)(tok0 - 15 + i) * DM + c0); }
#pragma unroll
            for (int j = 0; j < 8; ++j) {
                const int i = ib + j;
                W[j] = (i <= 30) ? *(const LAS f32x4*)(wl + i * 1024 + c0) : (f32x4){0.f, 0.f, 0.f, 0.f};
                const f32x4 x = (f32x4){bf_lo(xc[j].x), bf_hi(xc[j].x), bf_lo(xc[j].y), bf_hi(xc[j].y)};
#pragma unroll
                for (int o = 0; o < 8; ++o) acc[o] += x * W[(j - o) & 7];
            }
        }
#pragma unroll
        for (int o = 0; o < 8; ++o) { const f32x4 a = acc[o]; float s1 = (a[0] + a[1]) + (a[2] + a[3]), s2 = (a[0] * a[0] + a[1] * a[1]) + (a[2] * a[2] + a[3] * a[3]);
            s1 = wave_sum(s1); s2 = wave_sum(s2);
            if (lane == 0) { red[(wave * 8 + o) * 2] = s1; red[(wave * 8 + o) * 2 + 1] = s2; } }
        __syncthreads();
        const f32x4 gg = *(const GAS f32x4*)(ng + c0), gb = *(const GAS f32x4*)(nb + c0);
#pragma unroll
        for (int o = 0; o < 8; ++o) {
            float s1 = 0.f, s2 = 0.f;
#pragma unroll
            for (int w = 0; w < 4; ++w) { s1 += red[((4 * tg + w) * 8 + o) * 2]; s2 += red[((4 * tg + w) * 8 + o) * 2 + 1]; }
            const float mean = s1 * (1.f / DM); float var = s2 * (1.f / DM) - mean * mean; var = var < 0.f ? 0.f : var; const float rstd = 1.0f / sqrtf(var + LN_EPS);
            f32x4 t = (acc[o] - mean) * rstd * gg + gb;
#pragma unroll
            for (int c = 0; c < 4; ++c) t[c] = t[c] * pg8::sigmoidf_fast(t[c]);
            v2u w; w.x = pk2(t[0], t[1]); w.y = pk2(t[2], t[3]);
            pg8::st8(cout + (size_t)(tok0 + o) * DM + c0, w); }
        __syncthreads();
    }
}

constexpr int NPH = 15;
struct Args { const float* in[23]; float* out; unsigned char* ws; int ph_lo, ph_hi, li, pad; };
__global__ void __launch_bounds__(NTHR, 2) fwd_kernel(Args args) {
    extern __shared__ __attribute__((aligned(16))) unsigned char lds_raw[];
    LAS unsigned char* lds = (LAS unsigned char*)lds_raw;
    const int tid = threadIdx.x, lane = tid & 63, wave = __builtin_amdgcn_readfirstlane(tid >> 6);
    const int G = gridDim.x; const int bx = blockIdx.x; const int vcu = (G % 8 == 0) ? (bx % 8) * (G / 8) + bx / 8 : bx;
    Ptrs P;
#pragma unroll
    for (int i = 0; i < 23; ++i) P.in[i] = args.in[i];
    P.out = args.out; P.ws = args.ws;
    unsigned char* ws = args.ws;
    gu32* ctl = (gu32*)(ws + WS_CTL);
    for (int u = tid; u < (LDS_BYTES - LDSCTL_OFF) / 4; u += NTHR) ((LAS unsigned*)(lds + LDSCTL_OFF))[u] = 0u;
    __syncthreads();
    volatile LAS unsigned* MISC = (volatile LAS unsigned*)(lds + MISC_OFF);
    XcdBarrier bar = xcd_barrier_post((unsigned*)(ctl + CW_BAR) + args.li * XCD_BAR_WORDS, MISC + 8);
    const int lo = args.ph_lo, hi = args.ph_hi;
#define IN(k) (lo <= (k) && (k) < hi)
#define SEAM(k) do { if (IN(k) && IN((k) + 1)) xcd_barrier(bar); } while (0)
    const float* ln_mix_g = P.in[19]; const float* ln_mix_b = P.in[20]; const float* ln_ffn_g = P.in[21]; const float* ln_ffn_b = P.in[22];
    pg8::bf16_t* vbuf = (pg8::bf16_t*)P.out;

    if (IN(0)) { p0_prologue(P, lds, vcu, G, tid, lane, wave); } SEAM(0);
    if (IN(1)) {
        pg8::Gemm g{(const pg8::bf16_t*)(ws + WS_XB), (const pg8::bf16_t*)(ws + WS_WQKV), 1024, 0, 0};
        pg8::StaticOrder S; S.init(NTOK / 256, NQKV / 256, G, bx);
        pg8::EpiQKV E{(pg8::bf16_t*)(ws + WS_QKV), (const float*)(ws + WS_COS), (const float*)(ws + WS_SIN), 0.125f * LOG2E};
        pg8::gemm_phase<0>(lds + RING_OFF, g, S, E);
    } SEAM(1);
    if (IN(2)) { attn_phase(P, lds, G, tid, lane, wave); } SEAM(2);
    if (IN(3)) {
        pg8::Gemm g{(const pg8::bf16_t*)(ws + WS_O), (const pg8::bf16_t*)(ws + WS_WO), 1024, 0, 0};
        pg8::StaticOrder S; S.init(NTOK / 256, DM / 256, G, bx);
        pg8::EpiResBf16<false> E{vbuf, (const void*)P.in[0], nullptr, DN_ALPHA};
        pg8::gemm_phase<0>(lds + RING_OFF, g, S, E);
    } SEAM(3);
    if (IN(4)) { ln_phase(vbuf, ln_mix_g, ln_mix_b, (bf16*)(ws + WS_X1B), vcu, G, lane, wave); } SEAM(4);
    if (IN(5)) {
        pg8::Gemm g{(const pg8::bf16_t*)(ws + WS_X1B), (const pg8::bf16_t*)(ws + WS_WGU), 1024, 0, 0};
        pg8::StaticOrder S; S.init(NTOK / 256, 2 * FF / 256, G, bx);
        pg8::EpiGated<0> E{(pg8::bf16_t*)(ws + WS_H), FF, nullptr, 0, HBLK};
#if PROBE_SPLIT
        S.i1 = 7; pg8::gemm_phase<0>(lds + RING_OFF, g, S, E); xcd_barrier(bar); S.i0 = 7; S.i1 = 1 << 30;
#endif
        pg8::gemm_phase<0>(lds + RING_OFF, g, S, E);
    } SEAM(5);
    if (IN(6)) {
        pg8::Gemm g{(const pg8::bf16_t*)(ws + WS_H), (const pg8::bf16_t*)(ws + WS_WDN), FF, 0, HBLK};
        pg8::StaticOrder S; S.init(NTOK / 256, DM / 256, G, bx);
        pg8::EpiResBf16<true> E{vbuf, (const void*)(ws + WS_X1B), nullptr, DN_ALPHA};
        pg8::gemm_phase<0>(lds + RING_OFF, g, S, E);
    } SEAM(6);
    if (IN(7)) { ln_phase(vbuf, ln_ffn_g, ln_ffn_b, (bf16*)(ws + WS_X2B), vcu, G, lane, wave); } SEAM(7);
    if (IN(8)) {
        pg8::Gemm g{(const pg8::bf16_t*)(ws + WS_X2B), (const pg8::bf16_t*)(ws + WS_WPW1), 1024, 0, 0};
        pg8::StaticOrder S; S.init(NTOK / 256, 2048 / 256, G, bx);
        pg8::EpiGated<1> E{(pg8::bf16_t*)(ws + WS_G1), DM, P.in[5], 1024, 0};
        pg8::gemm_phase<0>(lds + RING_OFF, g, S, E);
    } SEAM(8);
    if (IN(9)) { conv_phase(P, lds, G, tid, lane, wave); } SEAM(9);
    if (IN(10)) {
        pg8::Gemm g{(const pg8::bf16_t*)(ws + WS_C1), (const pg8::bf16_t*)(ws + WS_WPW2), 1024, 0, 0};
        pg8::StaticOrder S; S.init(NTOK / 256, DM / 256, G, bx);
        pg8::EpiResBf16<true> E{(pg8::bf16_t*)(ws + WS_VPW2), (const void*)(ws + WS_X2B), P.in[11], DN_ALPHA};
        pg8::gemm_phase<0>(lds + RING_OFF, g, S, E);
    } SEAM(10);
    if (IN(11)) { ln_router_phase(P, lds, (const bf16*)(ws + WS_VPW2), ln_mix_g + DM, ln_mix_b + DM, (bf16*)P.out, G, tid, lane, wave); } SEAM(11);
    if (IN(12)) { route_phase(P, lds, G, tid, lane, wave); } SEAM(12);
    if (IN(13)) {
        LAS int* tsl = (LAS int*)(lds + TAB_OFF);
        if (!IN(12)) {
            __syncthreads();
            LAS int* tot = (LAS int*)(lds + RING_OFF);
            if (tid < 8) tot[tid] = 0;
            __syncthreads();
            { const int e = tid & 7; int a = 0; const int* wgcnt = (const int*)(ws + WS_WGCNT);
              for (int w = tid >> 3; w < G; w += NTHR / 8) a += wgcnt[w * 8 + e];
              atomicAdd((int*)(tot + e), a); }
            __syncthreads();
            if (tid == 0) { int t = 0; for (int e = 0; e < 8; ++e) { tsl[e] = t; t += (tot[e] + 255) >> 8; } tsl[8] = t; }
            __syncthreads();
        }
        int ts[9];
#pragma unroll
        for (int e = 0; e < 9; ++e) ts[e] = __builtin_amdgcn_readfirstlane(tsl[e]);
        const int ntile = ts[8];
        for (int t0 = 0; t0 < ntile; t0 += MOE_CHUNK_TILES) {
            const int nT = (ntile - t0) < MOE_CHUNK_TILES ? (ntile - t0) : MOE_CHUNK_TILES;
            {
                pg8::Gemm g{(const pg8::bf16_t*)(ws + WS_XS + (size_t)t0 * 256 * DM), (const pg8::bf16_t*)(ws + WS_MWGU), 512, (size_t)7168 * 1024, 0};
                pg8::MoeOrder S; S.so.init(nT, 2 * FF / 256, G, bx); S.t0 = t0;
#pragma unroll
                for (int e = 0; e < 9; ++e) S.ts[e] = ts[e];
                pg8::EpiGated8 E{ws + WS_HC, FF, 1.f, SH8};
                pg8::gemm_phase<2>(lds + RING_OFF, g, S, E);
            }
            xcd_barrier(bar);
            {
                pg8::Gemm g{(const pg8::bf16_t*)(ws + WS_HC), (const pg8::bf16_t*)(ws + WS_MWDN), FF / 2, (size_t)1024 * FF, 1};
                pg8::MoeOrder S; S.so.init(nT, DM / 256, G, bx); S.t0 = t0;
#pragma unroll
                for (int e = 0; e < 9; ++e) S.ts[e] = ts[e];
                pg8::EpiPlainBf16 E{(pg8::bf16_t*)(ws + WS_YS) + (size_t)t0 * 256 * DM, DM, 1.f / (SH8 * SD8)};
                pg8::gemm_phase<1>(lds + RING_OFF, g, S, E);
            }
            if (t0 + MOE_CHUNK_TILES < ntile) xcd_barrier(bar);
        }
    } SEAM(13);
    if (IN(14)) { combine_phase(P, ln_ffn_g + DM, ln_ffn_b + DM, vcu, G, lane, wave); }
#undef IN
#undef SEAM
}

extern "C" void kernel_launch(void* const* d_in, const int* in_sizes, int n_in, void* d_out, int out_size, void* d_ws, size_t ws_size, hipStream_t stream) {
    static int grid = 0;
    if (grid == 0) {
        if (n_in != 23 || in_sizes[0] != NTOK * DM || out_size != NTOK * DM || ws_size < WS_END) { fprintf(stderr, "kernel_launch: unexpected shapes (n_in %d, ws %zu)\n", n_in, ws_size); grid = -1; return; }
        int dev = 0, cus = 0, per_cu = 0;
        if (hipGetDevice(&dev) != hipSuccess || hipDeviceGetAttribute(&cus, hipDeviceAttributeMultiprocessorCount, dev) != hipSuccess) { grid = -1; return; }
        if (hipFuncSetAttribute((const void*)fwd_kernel, hipFuncAttributeMaxDynamicSharedMemorySize, LDS_BYTES) != hipSuccess) { grid = -1; return; }
        if (hipOccupancyMaxActiveBlocksPerMultiprocessor(&per_cu, (const void*)fwd_kernel, NTHR, LDS_BYTES) != hipSuccess || per_cu < 1) fprintf(stderr, "kernel_launch: occupancy query says %d\n", per_cu);
        (void)hipGetLastError();
        grid = cus;
    }
    if (grid < 0) return;
    if (hipMemsetAsync((char*)d_ws + WS_CTL, 0, CTL_ZERO_BYTES, stream) != hipSuccess) return;
    Args a{};
    for (int i = 0; i < 23; ++i) a.in[i] = (const float*)d_in[i];
    a.out = (float*)d_out; a.ws = (unsigned char*)d_ws;
    constexpr int NL = MK_N_LAUNCHES;
    static_assert(NL == 1 || NL == NPH, "MK_N_LAUNCHES is 1 or NPH");
#ifdef PROBE_PRE_HI
    a.ph_lo = PROBE_PRE_LO; a.ph_hi = PROBE_PRE_HI; a.li = 20; hipLaunchKernelGGL(fwd_kernel, dim3(grid), dim3(NTHR), LDS_BYTES, stream, a);
#endif
    for (int li = 0; li < NL; ++li) {
        a.ph_lo = (NL == 1) ? 0 : li; a.ph_hi = (NL == 1) ? NPH : li + 1; a.li = li;
        hipLaunchKernelGGL(fwd_kernel, dim3(grid), dim3(NTHR), LDS_BYTES, stream, a);
    }
}
```

```cpp
#include <hip/hip_runtime.h>
#include <cstdio>
#include <cstdint>
#include <cmath>

#ifndef PROBE_SPLIT
#define PROBE_SPLIT 0
#endif
#ifndef HBLK
#define HBLK 1
#endif
#ifndef MK_N_LAUNCHES
#define MK_N_LAUNCHES 1
#endif

namespace pg8 {
#define PG8_LAS __attribute__((address_space(3)))
typedef unsigned short bf16_t;
typedef short bf16x8 __attribute__((ext_vector_type(8)));
typedef float f32x4 __attribute__((ext_vector_type(4)));
typedef float f32x2 __attribute__((ext_vector_type(2)));
typedef unsigned u32x4 __attribute__((ext_vector_type(4)));
typedef unsigned u32x2 __attribute__((ext_vector_type(2)));
constexpr int BM = 256, BK = 64, HALF = 128, HTB = HALF * BK * 2, STAGE_BYTES = 8 * HTB, NXCD = 8, WGM = 8;

__host__ __device__ __forceinline__ int lds_byte(int r, int c) { const int st = (r >> 4) * 2 + (c >> 5), rr = r & 15, cc = c & 31, ob = rr * 64 + cc * 2; return st * 1024 + (ob ^ (((ob >> 9) & 1) << 5)); }
__host__ __device__ __forceinline__ void stage_rc(int b, int& R, int& C) { const int st = b / 1024, sb = b % 1024, swz = sb ^ (((sb >> 9) & 1) << 5); R = (st >> 1) * 16 + swz / 64; C = (st & 1) * 32 + (swz % 64) / 2; }
__host__ __device__ __forceinline__ int perm32(int rho) { const int n = rho >> 4, i = rho & 15; return 8 * (i >> 2) + 4 * n + (i & 3); }

struct Unit { int pm, pn, e; };
__host__ __device__ __forceinline__ size_t blk_off8(int row, int kb, int Kb) { return ((size_t)(row >> 8) * (Kb >> 7) + (kb >> 7)) * 32768 + (row & 255) * 128 + (kb & 127); }
struct Gemm { const bf16_t* A; const bf16_t* Bt; int K; size_t estride; int ablk; };

struct StaticOrder {
    int nM, nN, nwg, G, c; int i0 = 0, i1 = 1 << 30;
    __device__ __forceinline__ void init(int nM_, int nN_, int G_, int c_) { nM = nM_; nN = nN_; nwg = nM * nN; G = G_; c = c_; }
    __device__ __forceinline__ bool next(int i, Unit& u) const {
        if (i + i0 >= i1) return false; const long L = (long)(i + i0) * G + c; if (L >= nwg) return false;
        int wgid = (int)L; { const int q = nwg / NXCD, r = nwg % NXCD, xcd = wgid % NXCD, off = wgid / NXCD; wgid = (xcd < r ? xcd * (q + 1) : r * (q + 1) + (xcd - r) * q) + off; }
        const int nig = WGM * nN, gid = wgid / nig, fm = gid * WGM, gsz = (nM - fm) < WGM ? (nM - fm) : WGM;
        u.pm = fm + ((wgid % nig) % gsz); u.pn = (wgid % nig) / gsz; u.e = 0; return true;
    }
};
struct MoeOrder {
    StaticOrder so; int t0; int ts[9];
    __device__ __forceinline__ bool next(int i, Unit& u) const {
        if (!so.next(i, u)) return false;
        const int gt = t0 + u.pm; int e = 0;
#pragma unroll
        for (int j = 1; j < 8; ++j) e += (gt >= ts[j]) ? 1 : 0;
        u.e = e; return true;
    }
};

__device__ __forceinline__ unsigned cvt_pk_bf16(float lo, float hi) { unsigned r; asm volatile("v_cvt_pk_bf16_f32 %0, %1, %2" : "=v"(r) : "v"(lo), "v"(hi)); return r; }

typedef int i32x8 __attribute__((ext_vector_type(8)));
typedef int i32x4 __attribute__((ext_vector_type(4)));
__device__ __forceinline__ i32x8 cat8(bf16x8 a, bf16x8 b) { const i32x4 x = __builtin_bit_cast(i32x4, a), y = __builtin_bit_cast(i32x4, b); return (i32x8){x[0], x[1], x[2], x[3], y[0], y[1], y[2], y[3]}; }
__device__ __forceinline__ const char* addp(const char* base, unsigned off) {
    const unsigned long long b = (unsigned long long)base; const unsigned blo = (unsigned)b, bhi = (unsigned)(b >> 32); unsigned lo, hi;
    asm volatile("v_add_co_u32 %0, vcc, %2, %3\n\tv_addc_co_u32 %1, vcc, %4, 0, vcc" : "=&v"(lo), "=v"(hi) : "s"(blo), "v"(off), "s"(bhi) : "vcc");
    return (const char*)(((unsigned long long)hi << 32) | lo);
}
__device__ __forceinline__ float clamp448(float v) { return __builtin_fminf(__builtin_fmaxf(v, -448.f), 448.f); }
__device__ __forceinline__ unsigned pk4_fp8(float a, float b, float c, float d) {
    int r = __builtin_amdgcn_cvt_pk_fp8_f32(clamp448(a), clamp448(b), 0, false); r = __builtin_amdgcn_cvt_pk_fp8_f32(clamp448(c), clamp448(d), r, true); return (unsigned)r; }
typedef float f32x16 __attribute__((ext_vector_type(16)));
typedef unsigned u32x6 __attribute__((ext_vector_type(6)));
__device__ __forceinline__ void cvt_block6(const f32x16& a, const f32x16& b, u32x4& c0, u32x4& c1) {
    float mx = 0.f;
#pragma unroll
    for (int i = 0; i < 16; ++i) mx = __builtin_fmaxf(mx, __builtin_fmaxf(__builtin_fabsf(a[i]), __builtin_fabsf(b[i])));
    int e = (int)((__float_as_uint(mx * 1.0666667f) >> 23) & 0xffu) - 127 - 2;
    e = e < -100 ? -100 : (e > 100 ? 100 : e);
    const float inv = __uint_as_float((unsigned)(127 - e) << 23);
    f32x16 x, y;
#pragma unroll
    for (int i = 0; i < 16; ++i) { x[i] = __builtin_fminf(__builtin_fmaxf(a[i] * inv, -7.5f), 7.5f); y[i] = __builtin_fminf(__builtin_fmaxf(b[i] * inv, -7.5f), 7.5f); }
    const u32x6 r = __builtin_amdgcn_cvt_scalef32_2xpk16_fp6_f32(x, y, 1.0f);
    c0 = (u32x4){r[0], r[1], r[2], r[3]}; c1 = (u32x4){r[4], r[5], (unsigned)(e + 127), 0u};
}
#ifndef WT_STORES
#define WT_STORES 0
#endif
__device__ __forceinline__ void st16(void* p, u32x4 v) {
#if WT_STORES
    asm volatile("global_store_dwordx4 %0, %1, off sc1" :: "v"(p), "v"(v) : "memory");
#else
    *(u32x4*)p = v;
#endif
}
__device__ __forceinline__ void st8(void* p, u32x2 v) {
#if WT_STORES
    asm volatile("global_store_dwordx2 %0, %1, off sc1" :: "v"(p), "v"(v) : "memory");
#else
    *(u32x2*)p = v;
#endif
}

struct EpiQKV {
    static constexpr bool PERM = true;
    bf16_t* O; const float* ctab; const float* stab; float qscale;
    __device__ __forceinline__ void operator()(const f32x4 (&acc)[2][2][4][2], const Unit& u, int wr, int wc, int fr, int fq) const {
        const int row0 = u.pm * BM + wr * 64 + fr, col0 = u.pn * BM + wc * 32 + 8 * fq;
        const int j0 = 16 * (wc & 1) + 4 * fq;
        const bool rope = u.pn < 5; const float sc = u.pn < 4 ? qscale : 1.f;
#pragma unroll
        for (int ai = 0; ai < 2; ++ai)
#pragma unroll
            for (int m = 0; m < 4; ++m) {
                const int row = row0 + ai * HALF + m * 16; const int pos = row & 8191;
                f32x4 cs = (f32x4){1.f, 1.f, 1.f, 1.f}, sn = (f32x4){0.f, 0.f, 0.f, 0.f};
                if (rope) { cs = *(const f32x4*)(ctab + pos * 32 + j0); sn = *(const f32x4*)(stab + pos * 32 + j0); }
                bf16_t* rowp = O + (size_t)row * 1536 + col0;
#pragma unroll
                for (int bj = 0; bj < 2; ++bj) {
                    const f32x4 v0 = acc[ai][bj][m][0], v1 = acc[ai][bj][m][1];
                    const f32x4 o0 = (v0 * cs - v1 * sn) * sc, o1 = (v1 * cs + v0 * sn) * sc;
                    u32x4 w; w.x = cvt_pk_bf16(o0[0], o0[1]); w.y = cvt_pk_bf16(o0[2], o0[3]); w.z = cvt_pk_bf16(o1[0], o1[1]); w.w = cvt_pk_bf16(o1[2], o1[3]);
                    st16(rowp + bj * HALF, w); }
            }
    }
};
__device__ __forceinline__ float sigmoidf_fast(float x) { return __builtin_amdgcn_rcpf(1.f + __builtin_amdgcn_exp2f(-1.4426950408889634f * x)); }
template <int MODE> struct EpiGated {
    static constexpr bool PERM = true;
    bf16_t* O; int ldo; const float* bias; int bias_half; int oblk;
    __device__ __forceinline__ void operator()(const f32x4 (&acc)[2][2][4][2], const Unit& u, int wr, int wc, int fr, int fq) const {
        const int row0 = u.pm * BM + wr * 64 + fr, col0 = u.pn * HALF + wc * 16 + 4 * fq;
        f32x4 ba[2], bb[2];
#pragma unroll
        for (int bj = 0; bj < 2; ++bj) { if (MODE == 1) { ba[bj] = *(const f32x4*)(bias + col0 + bj * 64); bb[bj] = *(const f32x4*)(bias + bias_half + col0 + bj * 64); } else { ba[bj] = (f32x4){0.f, 0.f, 0.f, 0.f}; bb[bj] = ba[bj]; } }
#pragma unroll
        for (int ai = 0; ai < 2; ++ai)
#pragma unroll
            for (int m = 0; m < 4; ++m) {
                const int row = row0 + ai * HALF + m * 16;
                bf16_t* rowp = oblk ? O + ((size_t)(row >> 8) * (ldo >> 6) + (col0 >> 6)) * 16384 + (row & 255) * 64 + (col0 & 63) : O + (size_t)row * ldo + col0;
                const int bjs = oblk ? 16384 : 64;
#pragma unroll
                for (int bj = 0; bj < 2; ++bj) {
                    const f32x4 a = acc[ai][bj][m][0] + ba[bj], b = acc[ai][bj][m][1] + bb[bj]; f32x4 o;
#pragma unroll
                    for (int i = 0; i < 4; ++i) o[i] = (MODE == 0) ? a[i] * sigmoidf_fast(a[i]) * b[i] : a[i] * sigmoidf_fast(b[i]);
                    u32x2 w; w.x = cvt_pk_bf16(o[0], o[1]); w.y = cvt_pk_bf16(o[2], o[3]);
                    st8(rowp + bj * bjs, w); }
            }
    }
};
struct EpiGated8 {
    static constexpr bool PERM = true;
    unsigned char* O; int ldo; float inv, hs;
    __device__ __forceinline__ void operator()(const f32x4 (&acc)[2][2][4][2], const Unit& u, int wr, int wc, int fr, int fq) const {
        const int row0 = u.pm * BM + wr * 64 + fr, col0 = u.pn * HALF + wc * 32 + 8 * fq;
#pragma unroll
        for (int ai = 0; ai < 2; ++ai)
#pragma unroll
            for (int m = 0; m < 4; ++m) {
                unsigned char* rowp = O + blk_off8(row0 + ai * HALF + m * 16, col0, ldo); u32x2 w;
#pragma unroll
                for (int bj = 0; bj < 2; ++bj) { const f32x4 a = acc[ai][bj][m][0] * inv, b = acc[ai][bj][m][1] * inv; f32x4 o;
#pragma unroll
                    for (int i = 0; i < 4; ++i) o[i] = a[i] * sigmoidf_fast(a[i]) * b[i] * hs;
                    const unsigned p = pk4_fp8(o[0], o[1], o[2], o[3]); if (bj == 0) w.x = p; else w.y = p; }
                st8(rowp, w);
            }
    }
};
template <bool RESB> struct EpiResBf16 {
    static constexpr bool PERM = true;
    bf16_t* O; const void* res; const float* bias; float alpha;
    __device__ __forceinline__ void operator()(const f32x4 (&acc)[2][2][4][2], const Unit& u, int wr, int wc, int fr, int fq) const {
        const int row0 = u.pm * BM + wr * 64 + fr, col0 = u.pn * BM + wc * 32 + 8 * fq;
        f32x4 bv[2][2];
#pragma unroll
        for (int bj = 0; bj < 2; ++bj)
#pragma unroll
            for (int n = 0; n < 2; ++n) bv[bj][n] = bias ? *(const f32x4*)(bias + col0 + bj * HALF + 4 * n) : (f32x4){0.f, 0.f, 0.f, 0.f};
#pragma unroll
        for (int ai = 0; ai < 2; ++ai)
#pragma unroll
            for (int m = 0; m < 4; ++m) {
                const size_t off = (size_t)(row0 + ai * HALF + m * 16) * 1024 + col0;
#pragma unroll
                for (int bj = 0; bj < 2; ++bj) {
                    f32x4 r0, r1;
                    if (RESB) { const u32x4 w = *(const u32x4*)((const bf16_t*)res + off + bj * HALF);
                        r0 = (f32x4){__uint_as_float(w.x << 16), __uint_as_float(w.x & 0xffff0000u), __uint_as_float(w.y << 16), __uint_as_float(w.y & 0xffff0000u)};
                        r1 = (f32x4){__uint_as_float(w.z << 16), __uint_as_float(w.z & 0xffff0000u), __uint_as_float(w.w << 16), __uint_as_float(w.w & 0xffff0000u)}; }
                    else { r0 = *(const f32x4*)((const float*)res + off + bj * HALF); r1 = *(const f32x4*)((const float*)res + off + bj * HALF + 4); }
                    const f32x4 v0 = r0 * alpha + acc[ai][bj][m][0] + bv[bj][0], v1 = r1 * alpha + acc[ai][bj][m][1] + bv[bj][1];
                    u32x4 w; w.x = cvt_pk_bf16(v0[0], v0[1]); w.y = cvt_pk_bf16(v0[2], v0[3]); w.z = cvt_pk_bf16(v1[0], v1[1]); w.w = cvt_pk_bf16(v1[2], v1[3]);
                    st16(O + off + bj * HALF, w); }
            }
    }
};
struct EpiPlainBf16 {
    static constexpr bool PERM = true;
    bf16_t* O; int ldo; float sc;
    __device__ __forceinline__ void operator()(const f32x4 (&acc)[2][2][4][2], const Unit& u, int wr, int wc, int fr, int fq) const {
        const int row0 = u.pm * BM + wr * 64 + fr, col0 = u.pn * BM + wc * 32 + 8 * fq;
#pragma unroll
        for (int ai = 0; ai < 2; ++ai)
#pragma unroll
            for (int m = 0; m < 4; ++m) { bf16_t* rowp = O + (size_t)(row0 + ai * HALF + m * 16) * ldo + col0;
#pragma unroll
                for (int bj = 0; bj < 2; ++bj) { const f32x4 v0 = acc[ai][bj][m][0] * sc, v1 = acc[ai][bj][m][1] * sc;
                    u32x4 w; w.x = cvt_pk_bf16(v0[0], v0[1]); w.y = cvt_pk_bf16(v0[2], v0[3]); w.z = cvt_pk_bf16(v1[0], v1[1]); w.w = cvt_pk_bf16(v1[2], v1[3]);
                    st16(rowp + bj * HALF, w); } }
    }
};

template <int MODE, class Epi, class Sched>
__device__ __forceinline__ void gemm_phase(PG8_LAS unsigned char* lds, const Gemm g, const Sched& S, const Epi& E) {
    const int tid = threadIdx.x, wid = __builtin_amdgcn_readfirstlane(tid >> 6), lane = tid & 63, wr = wid >> 2, wc = wid & 3, fr = lane & 15, fq = lane >> 4;
    constexpr bool F8 = (MODE != 0);
    const int K = g.K, nt = K / BK;
    unsigned voffA[2], voffB[2];
#pragma unroll
    for (int i = 0; i < 2; ++i) { int R, C; stage_rc(tid * 16 + i * 8192, R, C); const int Rb = Epi::PERM ? ((R & ~31) + perm32(R & 31)) : R;
        voffA[i] = g.ablk ? (unsigned)(R * 128 + C * 2) : (unsigned)(R * K + C) * 2u; voffB[i] = (unsigned)(Rb * K + C) * 2u; }
    const unsigned kstep = (unsigned)(BK * 2);
    const unsigned hstep = (unsigned)HALF * (unsigned)K * 2u;
    const unsigned tstep = 2u * hstep;
    const unsigned kstepA = g.ablk ? 32768u : kstep, hstepA = g.ablk ? 16384u : hstep;
    const unsigned ldsw = (unsigned)wid * 1024u;
    const int aoff = lds_byte(wr * 64 + fr, fq * 8), boff = lds_byte(wc * 32 + fr, fq * 8);
    __amdgpu_buffer_rsrc_t rsA = __builtin_amdgcn_make_buffer_rsrc((void*)g.A, 0, 0x7fffffff, 0x00020000), rsB = __builtin_amdgcn_make_buffer_rsrc((void*)g.Bt, 0, 0x7fffffff, 0x00020000);
#define PG8_SA(b, h) (((b) * 2 + (h)) * HTB)
#define PG8_SB(b, h) ((4 + (b) * 2 + (h)) * HTB)
#define PG8_STAGE(bufoff, isA, uoff, voff) do { _Pragma("unroll") for (int _i = 0; _i < 2; ++_i) { \
        if constexpr (F8) __builtin_amdgcn_raw_ptr_buffer_load_lds((isA) ? rsA : rsB, (PG8_LAS void*)(lds + (bufoff) + ldsw + _i * 8192), 16, (voff)[_i], (uoff), 0, 0); \
        else __builtin_amdgcn_global_load_lds((const unsigned*)((const char*)((isA) ? (const void*)g.A : (const void*)g.Bt) + (size_t)(uoff) + (voff)[_i]), (PG8_LAS unsigned*)(lds + (bufoff) + ldsw + _i * 8192), 16, 0, 0); } } while (0)
#define PG8_LDA(dst, b, h) do { _Pragma("unroll") for (int m = 0; m < 4; ++m) _Pragma("unroll") for (int k = 0; k < 2; ++k) dst[m][k] = *(const PG8_LAS bf16x8*)(lds + PG8_SA(b, h) + aoff + m * 2048 + k * 1024); } while (0)
#define PG8_LDB(dst, b, h) do { _Pragma("unroll") for (int n = 0; n < 2; ++n) _Pragma("unroll") for (int k = 0; k < 2; ++k) dst[n][k] = *(const PG8_LAS bf16x8*)(lds + PG8_SB(b, h) + boff + n * 2048 + k * 1024); } while (0)
#define PG8_MMA(ai, bj, At, Bt) do { __builtin_amdgcn_s_setprio(1); _Pragma("unroll") for (int m = 0; m < 4; ++m) _Pragma("unroll") for (int n = 0; n < 2; ++n) { \
        if constexpr (MODE == 1) { acc[ai][bj][m][n] = __builtin_amdgcn_mfma_scale_f32_16x16x128_f8f6f4(cat8(Bt[n][0], Bt[n][1]), cat8(At[m][0], At[m][1]), acc[ai][bj][m][n], 0, 0, 0, 0x7f7f7f7f, 0, 0x7f7f7f7f); } \
        else if constexpr (MODE == 2) { const i32x8 b8_ = cat8(Bt[n][0], Bt[n][1]), a8_ = cat8(At[m][0], At[m][1]); acc[ai][bj][m][n] = __builtin_amdgcn_mfma_scale_f32_16x16x128_f8f6f4(b8_, a8_, acc[ai][bj][m][n], 2, 2, 0, b8_[6], 0, a8_[6]); } \
        else { _Pragma("unroll") for (int k = 0; k < 2; ++k) acc[ai][bj][m][n] = __builtin_amdgcn_mfma_f32_16x16x32_bf16(Bt[n][k], At[m][k], acc[ai][bj][m][n], 0, 0, 0); } } __builtin_amdgcn_s_setprio(0); } while (0)
#define PG8_WAIT_V(n) asm volatile("s_waitcnt vmcnt(" #n ")" ::: "memory")
#define PG8_WAIT_L(n) asm volatile("s_waitcnt lgkmcnt(" #n ")" ::: "memory")
#define PG8_BAR __builtin_amdgcn_s_barrier()
#define PG8_SCHED __builtin_amdgcn_sched_barrier(0)
    Unit cur, nxt; int ui = 0;
    if (!S.next(0, cur)) return;
    f32x4 acc[2][2][4][2];
#pragma unroll
    for (int a = 0; a < 2; ++a)
#pragma unroll
        for (int b = 0; b < 2; ++b)
#pragma unroll
            for (int m = 0; m < 4; ++m)
#pragma unroll
                for (int n = 0; n < 2; ++n) acc[a][b][m][n] = (f32x4){0.f, 0.f, 0.f, 0.f};
    bf16x8 At[4][2], B0[2][2], B1[2][2];
    unsigned cA = (unsigned)cur.pm * tstep, cB = (unsigned)cur.e * (unsigned)g.estride + (unsigned)cur.pn * tstep;
    PG8_STAGE(PG8_SB(0, 0), false, cB, voffB); PG8_STAGE(PG8_SB(0, 1), false, cB + hstep, voffB); PG8_STAGE(PG8_SA(0, 0), true, cA, voffA); PG8_STAGE(PG8_SA(0, 1), true, cA + hstepA, voffA);
    if (wr == 1) PG8_BAR;
    PG8_WAIT_V(2); PG8_BAR;
    PG8_STAGE(PG8_SB(1, 0), false, cB + kstep, voffB); PG8_STAGE(PG8_SA(1, 0), true, cA + kstepA, voffA); PG8_STAGE(PG8_SB(1, 1), false, cB + hstep + kstep, voffB);
    PG8_WAIT_V(6); PG8_BAR;
    for (;;) {
        const bool has_next = S.next(ui + 1, nxt);
        const unsigned nA = has_next ? (unsigned)nxt.pm * tstep : cA, nB = has_next ? (unsigned)nxt.e * (unsigned)g.estride + (unsigned)nxt.pn * tstep : cB;
#pragma unroll 1
        for (int t = 0; t < nt; t += 2) {
            const bool last = (t == nt - 2);
            const unsigned a1 = cA + (unsigned)(t + 1) * kstepA;
            const unsigned a2 = last ? nA : cA + (unsigned)(t + 2) * kstepA, b2 = last ? nB : cB + (unsigned)(t + 2) * kstep;
            const unsigned a3 = a2 + kstepA, b3 = b2 + kstep;
            PG8_LDB(B0, 0, 0); PG8_LDB(B1, 0, 1); PG8_SCHED; PG8_LDA(At, 0, 0); PG8_STAGE(PG8_SA(1, 1), true, a1 + hstepA, voffA);
            PG8_WAIT_V(8); PG8_WAIT_L(0); PG8_BAR; PG8_MMA(0, 0, At, B0); PG8_MMA(0, 1, At, B1); PG8_BAR; PG8_SCHED;
            PG8_LDA(At, 0, 1); PG8_STAGE(PG8_SB(0, 0), false, b2, voffB); PG8_STAGE(PG8_SB(0, 1), false, b2 + hstep, voffB); PG8_STAGE(PG8_SA(0, 0), true, a2, voffA);
            PG8_WAIT_V(8); PG8_WAIT_L(0); PG8_BAR; PG8_MMA(1, 0, At, B0); PG8_MMA(1, 1, At, B1); PG8_BAR; PG8_SCHED;
            PG8_LDB(B0, 1, 0); PG8_LDB(B1, 1, 1); PG8_SCHED; PG8_LDA(At, 1, 0); PG8_STAGE(PG8_SA(0, 1), true, a2 + hstepA, voffA);
            PG8_WAIT_V(8); PG8_WAIT_L(0); PG8_BAR; PG8_MMA(0, 0, At, B0); PG8_MMA(0, 1, At, B1); PG8_BAR; PG8_SCHED;
            PG8_LDA(At, 1, 1); PG8_STAGE(PG8_SB(1, 0), false, b3, voffB); PG8_STAGE(PG8_SB(1, 1), false, b3 + hstep, voffB); PG8_STAGE(PG8_SA(1, 0), true, a3, voffA);
            PG8_WAIT_V(8); PG8_WAIT_L(0); PG8_BAR; PG8_MMA(1, 0, At, B0); PG8_MMA(1, 1, At, B1); PG8_BAR; PG8_SCHED;
        }
        if (wr == 0) PG8_BAR;
        E(acc, cur, wr, wc, fr, fq);
        if (!has_next) break;
#pragma unroll
        for (int a = 0; a < 2; ++a)
#pragma unroll
            for (int b = 0; b < 2; ++b)
#pragma unroll
                for (int m = 0; m < 4; ++m)
#pragma unroll
                    for (int n = 0; n < 2; ++n) acc[a][b][m][n] = (f32x4){0.f, 0.f, 0.f, 0.f};
        cur = nxt; cA = nA; cB = nB; ++ui;
        if (wr == 1) PG8_BAR;
    }
    PG8_WAIT_V(0);
    PG8_BAR;
#undef PG8_SA
#undef PG8_SB
#undef PG8_STAGE
#undef PG8_LDA
#undef PG8_LDB
#undef PG8_MMA
#undef PG8_WAIT_V
#undef PG8_WAIT_L
#undef PG8_BAR
#undef PG8_SCHED
}
}

constexpr int NWAVES = 8, NTHR = 512;
constexpr int NTOK = 32768, SEQ = 8192, DM = 1024, NQKV = 1536, FF = 3584, NE = 8, NHEAD = 16, NKV = 4;
constexpr float LN_EPS = 1e-5f;
constexpr float DN_ALPHA = 1.4142135623730951f;
constexpr float LOG2E = 1.4426950408889634f;
constexpr int MOE_CHUNK_TILES = 264;
constexpr float SX8 = 4.f, SW8 = 128.f, SH8 = 8.f, SD8 = 512.f;
constexpr int MAX_TILES = 264;

constexpr size_t MiB = 1u << 20;
constexpr size_t WS_CTL = 0, CTL_ZERO_BYTES = 1 * MiB;
constexpr size_t WS_COS = 1 * MiB, WS_SIN = 2 * MiB;
constexpr size_t WS_TOPI = 3 * MiB, WS_GATE = WS_TOPI + 256 * 1024, WS_POS = WS_GATE + 256 * 1024, WS_WGCNT = WS_POS + 256 * 1024;
constexpr size_t WS_MWGU = 8 * MiB, WS_MWDN = 64 * MiB;
constexpr size_t WS_WQKV = 92 * MiB, WS_WO = 95 * MiB, WS_WPW1 = 97 * MiB, WS_WPW2 = 101 * MiB, WS_WGU = 103 * MiB, WS_WDN = 117 * MiB;
constexpr size_t WS_ACT = 124 * MiB;
constexpr size_t WS_XB = WS_ACT, WS_QKV = WS_ACT + 64 * MiB, WS_O = WS_ACT + 160 * MiB, WS_X1B = WS_ACT + 224 * MiB, WS_H = WS_ACT;
constexpr size_t WS_X2B = WS_ACT, WS_G1 = WS_ACT + 64 * MiB, WS_C1 = WS_ACT + 128 * MiB, WS_VPW2 = WS_ACT + 192 * MiB;
constexpr size_t WS_XS = 92 * MiB, WS_HC = 158 * MiB, WS_YS = 389 * MiB;
constexpr size_t WS_END = 521 * MiB;
constexpr int X3_STRIDE = 2048;
static_assert(WS_XS + (size_t)MAX_TILES * 256 * DM <= WS_HC && WS_HC + (size_t)MOE_CHUNK_TILES * 256 * FF <= WS_YS && WS_YS + (size_t)MAX_TILES * 256 * DM * 2 <= WS_END, "d_ws map (MoE)");
static_assert(WS_H + (size_t)NTOK * FF * 2 <= WS_X1B && WS_VPW2 + (size_t)NTOK * DM * 2 <= WS_END && WS_WDN + (size_t)DM * FF * 2 <= WS_ACT, "d_ws map");
constexpr int CW_TMO = 0, CW_CODE = 1, CW_BAR = 4096, CW_ITEM = 2048;

constexpr int RING_OFF = 0, RING_BYTES = 131072;
constexpr int LDSCTL_OFF = RING_BYTES, MISC_OFF = LDSCTL_OFF + 320, TAB_OFF = LDSCTL_OFF + 1024;
constexpr int LDS_BYTES = 147456;

#define GAS __attribute__((address_space(1)))
#define LAS __attribute__((address_space(3)))
typedef unsigned short bf16;
typedef unsigned v4u __attribute__((ext_vector_type(4)));
typedef unsigned v2u __attribute__((ext_vector_type(2)));
typedef float f32x4 __attribute__((ext_vector_type(4)));
typedef float f32x16 __attribute__((ext_vector_type(16)));
typedef short bf16x8 __attribute__((ext_vector_type(8)));
typedef short s16x4 __attribute__((ext_vector_type(4)));
typedef float f32x2v __attribute__((ext_vector_type(2)));
typedef GAS unsigned gu32;
#define RLX_AGENT __ATOMIC_RELAXED, __HIP_MEMORY_SCOPE_AGENT
#define LDS_WAIT() asm volatile("s_waitcnt lgkmcnt(0)" ::: "memory")
#define VM_WAIT() asm volatile("s_waitcnt vmcnt(0)" ::: "memory")
__device__ __forceinline__ unsigned pk2(float lo, float hi) { return pg8::cvt_pk_bf16(lo, hi); }
__device__ __forceinline__ float bf_lo(unsigned w) { return __uint_as_float(w << 16); }
__device__ __forceinline__ float bf_hi(unsigned w) { return __uint_as_float(w & 0xffff0000u); }

#define XB_TMO      128
#define XB_XCNT(j)  (256  + 64 * (j))
#define XB_XSUB(j)  (1280 + 64 * (j))
#define XB_XGEN(j)  (2304 + 64 * (j))
#define XB_TOP      3328
#define XB_TOPGEN   3392
#define XCD_BAR_WORDS 3456
#define XB_SPIN_CAP (1u << 18)
__device__ __forceinline__ unsigned xb_ld(unsigned* p)              { return __hip_atomic_load(p, __ATOMIC_RELAXED, __HIP_MEMORY_SCOPE_AGENT); }
__device__ __forceinline__ unsigned xb_add(unsigned* p, unsigned v) { return __hip_atomic_fetch_add(p, v, __ATOMIC_RELAXED, __HIP_MEMORY_SCOPE_AGENT); }
__device__ __forceinline__ unsigned xb_xcc_id() { return (unsigned)__builtin_amdgcn_s_getreg((3 << 11) | 20) & 0xFu; }
#define XB_SPIN(cond, bar) do { unsigned _sp = 0; while (cond) { __builtin_amdgcn_s_sleep(1); \
    if ((++_sp & 255u) == 0u) { if (xb_ld(&(bar)[XB_TMO])) break; if (_sp > XB_SPIN_CAP) { atomicAdd(&(bar)[XB_TMO], 1u); break; } } } } while (0)
struct XcdBarrier { unsigned* bar; unsigned x; volatile LAS unsigned* st; };
__device__ __forceinline__ XcdBarrier xcd_barrier_post(unsigned* bar, volatile LAS unsigned* st) {
    XcdBarrier b; b.bar = bar; b.x = xb_xcc_id(); b.st = st;
    if (threadIdx.x == 0) (void)xb_add(&bar[XB_XCNT(b.x)], 1u);
    return b;
}
__device__ __forceinline__ void xcd_barrier_complete(unsigned* bar, unsigned x, unsigned& nloc, unsigned& nx) {
    const unsigned G = gridDim.x * gridDim.y * gridDim.z;
    unsigned sum, cnt, mine, sp = 0u;
    for (;;) {
        sum = 0u; cnt = 0u; mine = 0u;
#pragma unroll
        for (unsigned j = 0; j < 16; ++j) { const unsigned c = xb_ld(&bar[XB_XCNT(j)]); sum += c; cnt += (c > 0u) ? 1u : 0u; mine = (j == x) ? c : mine; }
        if (sum == G) break;
        __builtin_amdgcn_s_sleep(1);
        if ((++sp & 255u) == 0u) { if (xb_ld(&bar[XB_TMO])) break; if (sp > XB_SPIN_CAP) { atomicAdd(&bar[XB_TMO], 1u); break; } }
    }
    nloc = mine > 0u ? mine : 1u; nx = cnt > 0u ? cnt : 1u;
}
__device__ __forceinline__ void xcd_barrier(const XcdBarrier& b) {
    asm volatile("s_waitcnt vmcnt(0)" ::: "memory");
    __syncthreads();
    if (threadIdx.x == 0) {
        unsigned* bar = b.bar;
        __builtin_amdgcn_s_waitcnt(0);
        unsigned nloc = b.st[0], nx = b.st[1];
        if (nloc == 0u) { xcd_barrier_complete(bar, b.x, nloc, nx); b.st[0] = nloc; b.st[1] = nx; }
        const unsigned old = xb_add(&bar[XB_XSUB(b.x)], 1u);
        const unsigned gen = old / nloc;
        if (old + 1u == (gen + 1u) * nloc) {
            __builtin_amdgcn_fence(__ATOMIC_RELEASE, "agent");
            asm volatile("s_waitcnt vmcnt(0)" ::: "memory");
            const unsigned og = xb_add(&bar[XB_TOP], 1u);
            const unsigned tg = og / nx;
            if (og + 1u == (tg + 1u) * nx) xb_add(&bar[XB_TOPGEN], 1u);
            else XB_SPIN(xb_ld(&bar[XB_TOPGEN]) == tg, bar);
            __builtin_amdgcn_fence(__ATOMIC_ACQUIRE, "agent");
            xb_add(&bar[XB_XGEN(b.x)], 1u);
            asm volatile("s_waitcnt vmcnt(0)" ::: "memory");
        } else {
            XB_SPIN(xb_ld(&bar[XB_XGEN(b.x)]) == gen, bar);
            __builtin_amdgcn_fence(__ATOMIC_ACQUIRE, "agent");
            asm volatile("s_waitcnt vmcnt(0)" ::: "memory");
        }
    }
    __syncthreads();
}

#define DPP_ADD(v, ctrl, row_mask) ((v) + __builtin_bit_cast(float, __builtin_amdgcn_update_dpp(0, __builtin_bit_cast(int, (v)), (ctrl), (row_mask), 0xF, false)))
__device__ __forceinline__ float wave_sum(float v) {
    v = DPP_ADD(v, 0x111, 0xF);
    v = DPP_ADD(v, 0x112, 0xF);
    v = DPP_ADD(v, 0x114, 0xF);
    v = DPP_ADD(v, 0x118, 0xF);
    v = DPP_ADD(v, 0x142, 0xA);
    v = DPP_ADD(v, 0x143, 0xC);
    return __builtin_bit_cast(float, __builtin_amdgcn_readlane(__builtin_bit_cast(int, v), 63));
}

struct Ptrs {
    const float* in[23]; float* out; unsigned char* ws; const float* inv_freq;
};

__device__ __forceinline__ int map_row(int kind, int n) {
    if (kind == 1) { if (n >= 1280) return n; const int d = n & 63; return (n & ~63) + 8 * ((d & 31) >> 2) + 4 * (d >> 5) + (d & 3); }
    if (kind == 2) return 8 * (n >> 2) + (n & 3);
    if (kind == 3) return 8 * (n >> 2) + 4 + (n & 3);
    if (kind == 4) { const int f = n & 1023; return 8 * (f >> 2) + 4 * (n >> 10) + (f & 3); }
    return n;
}
__device__ __forceinline__ void tr_item(const float* W, int N, int K, int k0, int n0, bf16* dst, int kind, LAS unsigned char* scr, int lane) {
    f32x4 v[16];
    const int c4 = lane & 15, kr = lane >> 4;
#pragma unroll
    for (int j = 0; j < 16; ++j) v[j] = *(const GAS f32x4*)(W + (size_t)(k0 + kr + 4 * j) * N + n0 + 4 * c4);
#pragma unroll
    for (int j = 0; j < 16; ++j) { v2u w; w.x = pk2(v[j][0], v[j][1]); w.y = pk2(v[j][2], v[j][3]); *(LAS v2u*)(scr + (kr + 4 * j) * 136 + c4 * 8) = w; }
    LDS_WAIT(); asm volatile("" ::: "memory");
    const int c = lane & 7;
#pragma unroll
    for (int j = 0; j < 8; ++j) {
        const int n = 8 * j + (lane >> 3); const LAS unsigned char* s = scr + (8 * c) * 136 + 2 * n;
        unsigned h[8];
#pragma unroll
        for (int i = 0; i < 8; ++i) h[i] = *(const LAS unsigned short*)(s + i * 136);
        v4u o; o.x = h[0] | (h[1] << 16); o.y = h[2] | (h[3] << 16); o.z = h[4] | (h[5] << 16); o.w = h[6] | (h[7] << 16);
        pg8::st16(dst + (size_t)map_row(kind, n0 + n) * K + k0 + 8 * c, o);
    }
    LDS_WAIT(); asm volatile("" ::: "memory");
}
__device__ __forceinline__ int map_row8(int which, int f) { return 256 * (f >> 7) + 128 * ((f >> 2) & 1) + 32 * ((f & 127) >> 5) + 8 * ((f >> 3) & 3) + 4 * which + (f & 3); }
__device__ __forceinline__ void tr_item8(const float* W, int N, int K, int k0, int n0, unsigned char* dst, int which, float scale, LAS unsigned char* scr, int lane) {
    f32x4 v[16];
    const int c4 = lane & 15, kr = lane >> 4;
#pragma unroll
    for (int j = 0; j < 16; ++j) v[j] = *(const GAS f32x4*)(W + (size_t)(k0 + kr + 4 * j) * N + n0 + 4 * c4);
#pragma unroll
    for (int j = 0; j < 16; ++j) *(LAS unsigned*)(scr + (kr + 4 * j) * 68 + c4 * 4) = pg8::pk4_fp8(v[j][0] * scale, v[j][1] * scale, v[j][2] * scale, v[j][3] * scale);
    LDS_WAIT(); asm volatile("" ::: "memory");
    const int c = lane & 3;
#pragma unroll
    for (int j = 0; j < 4; ++j) {
        const int n = 16 * j + (lane >> 2); const LAS unsigned char* sp = scr + (16 * c) * 68 + n;
        unsigned h[16];
#pragma unroll
        for (int i = 0; i < 16; ++i) h[i] = *(const LAS unsigned char*)(sp + i * 68);
        v4u o;
        o.x = h[0] | (h[1] << 8) | (h[2] << 16) | (h[3] << 24); o.y = h[4] | (h[5] << 8) | (h[6] << 16) | (h[7] << 24);
        o.z = h[8] | (h[9] << 8) | (h[10] << 16) | (h[11] << 24); o.w = h[12] | (h[13] << 8) | (h[14] << 16) | (h[15] << 24);
        const int drow = which < 0 ? (n0 + n) : map_row8(which, n0 + n);
        pg8::st16(dst + (size_t)drow * K + k0 + 16 * c, o);
    }
    LDS_WAIT(); asm volatile("" ::: "memory");
}
__device__ __forceinline__ void tr_item6(const float* W, int N, int K, int k0, int n0, unsigned char* dst, int which, LAS unsigned char* scr, int lane) {
    LAS float* sf = (LAS float*)scr;
    { const int c4 = lane & 7, kr = lane >> 3;
#pragma unroll
      for (int j = 0; j < 16; ++j) { const f32x4 v = *(const GAS f32x4*)(W + (size_t)(k0 + kr + 8 * j) * N + n0 + 4 * c4); *(LAS f32x4*)(sf + (kr + 8 * j) * 32 + 4 * c4) = v; } }
    LDS_WAIT(); asm volatile("" ::: "memory");
    const int n = lane & 31, half = lane >> 5;
    unsigned char* drow = dst + (size_t)map_row8(which, n0 + n) * K + k0;
#pragma unroll
    for (int blk = 0; blk < 2; ++blk) {
        const int kb = 64 * half + 32 * blk, g = 2 * half + blk;
        pg8::f32x16 a, b;
#pragma unroll
        for (int i = 0; i < 16; ++i) { a[i] = sf[(kb + i) * 32 + n]; b[i] = sf[(kb + 16 + i) * 32 + n]; }
        pg8::u32x4 c0, c1; pg8::cvt_block6(a, b, c0, c1);
        pg8::st16(drow + 16 * g, c0); pg8::st16(drow + 64 + 16 * g, c1);
    }
    LDS_WAIT(); asm volatile("" ::: "memory");
}
__device__ __forceinline__ void p0_prologue(const Ptrs& P, LAS unsigned char* lds, int vcu, int G, int tid, int lane, int wave) {
    unsigned char* ws = P.ws;
    constexpr int SROW = 520;
    LAS unsigned char* scr = lds + RING_OFF;
    LAS int* cur_item = (LAS int*)(lds + TAB_OFF + 256);
    unsigned* ictr = (unsigned*)(ws + WS_CTL) + CW_ITEM;
    constexpr int I_QKV = 8 * 6, I_WO = 8 * 4, I_PW1 = 8 * 8, I_PW2 = 8 * 4, I_G = 8 * 14, I_DN = 28 * 4;
    constexpr int B0 = 0, B1 = B0 + I_QKV, B2 = B1 + I_WO, B3 = B2 + I_PW1, B4 = B3 + I_PW2, B5 = B4 + I_G, B6 = B5 + I_G, B7 = B6 + I_DN, B8 = B7 + 8 * I_G, B9 = B8 + 8 * I_G, B10 = B9 + 8 * I_DN;
    for (;;) {
        __syncthreads();
        if (tid == 0) cur_item[0] = (int)__hip_atomic_fetch_add(ictr, 1u, __ATOMIC_RELAXED, __HIP_MEMORY_SCOPE_AGENT);
        __syncthreads();
        const int it = cur_item[0];
        if (it >= B10) break;
        const float* W; int N, K, r; int mode;
        unsigned char* dst;
        if (it < B1)      { r = it - B0; W = P.in[1];  K = 1024; N = 1536; mode = 1; dst = ws + WS_WQKV; }
        else if (it < B2) { r = it - B1; W = P.in[3];  K = 1024; N = 1024; mode = 0; dst = ws + WS_WO; }
        else if (it < B3) { r = it - B2; W = P.in[4];  K = 1024; N = 2048; mode = 4; dst = ws + WS_WPW1; }
        else if (it < B4) { r = it - B3; W = P.in[10]; K = 1024; N = 1024; mode = 0; dst = ws + WS_WPW2; }
        else if (it < B5) { r = it - B4; W = P.in[12]; K = 1024; N = 3584; mode = 2; dst = ws + WS_WGU; }
        else if (it < B6) { r = it - B5; W = P.in[13]; K = 1024; N = 3584; mode = 3; dst = ws + WS_WGU; }
        else if (it < B7) { r = it - B6; W = P.in[14]; K = 3584; N = 1024; mode = 0; dst = ws + WS_WDN; }
        else if (it < B8) { r = it - B7; const int e = r / I_G; r -= e * I_G; W = P.in[16] + (size_t)e * 1024 * 3584; K = 1024; N = 3584; mode = 5; dst = ws + WS_MWGU + (size_t)e * 7168 * 1024; }
        else if (it < B9) { r = it - B8; const int e = r / I_G; r -= e * I_G; W = P.in[17] + (size_t)e * 1024 * 3584; K = 1024; N = 3584; mode = 6; dst = ws + WS_MWGU + (size_t)e * 7168 * 1024; }
        else              { r = it - B9; const int e = r / I_DN; r -= e * I_DN; W = P.in[18] + (size_t)e * 3584 * 1024; K = 3584; N = 1024; mode = 7; dst = ws + WS_MWDN + (size_t)e * 1024 * 3584; }
        const int nblk = N / 256, kb = r / nblk, nb = r - kb * nblk, k0 = kb * 128, n0 = nb * 256;
        {
            f32x4 v[16];
#pragma unroll
            for (int j = 0; j < 16; ++j) v[j] = *(const GAS f32x4*)(W + (size_t)(k0 + wave * 16 + j) * N + n0 + 4 * lane);
#pragma unroll
            for (int j = 0; j < 16; ++j) { v2u w2; w2.x = pk2(v[j][0], v[j][1]); w2.y = pk2(v[j][2], v[j][3]); *(LAS v2u*)(scr + (wave * 16 + j) * SROW + 8 * lane) = w2; }
        }
        __syncthreads();
        const int n = tid & 255, half = tid >> 8;
        const LAS unsigned char* col = scr + 2 * n;
        if (mode <= 4) {
            bf16* drow = (bf16*)dst + (size_t)map_row(mode, n0 + n) * K + k0 + 64 * half;
#pragma unroll
            for (int c = 0; c < 8; ++c) { unsigned h[8];
#pragma unroll
                for (int i = 0; i < 8; ++i) h[i] = *(const LAS unsigned short*)(col + (64 * half + 8 * c + i) * SROW);
                v4u o; o.x = h[0] | (h[1] << 16); o.y = h[2] | (h[3] << 16); o.z = h[4] | (h[5] << 16); o.w = h[6] | (h[7] << 16);
                pg8::st16(drow + 8 * c, o); }
        } else if (mode == 7) {
            unsigned char* drow = dst + (size_t)(n0 + n) * K + k0 + 64 * half;
#pragma unroll
            for (int c = 0; c < 4; ++c) { float f[16];
#pragma unroll
                for (int i = 0; i < 16; ++i) f[i] = bf_lo((unsigned)*(const LAS unsigned short*)(col + (64 * half + 16 * c + i) * SROW)) * SD8;
                v4u o; o.x = pg8::pk4_fp8(f[0], f[1], f[2], f[3]); o.y = pg8::pk4_fp8(f[4], f[5], f[6], f[7]); o.z = pg8::pk4_fp8(f[8], f[9], f[10], f[11]); o.w = pg8::pk4_fp8(f[12], f[13], f[14], f[15]);
                pg8::st16(drow + 16 * c, o); }
        } else {
            unsigned char* drow = dst + (size_t)map_row8(mode - 5, n0 + n) * K + k0;
#pragma unroll
            for (int blk = 0; blk < 2; ++blk) { const int g = 2 * half + blk; pg8::f32x16 a, b;
#pragma unroll
                for (int i = 0; i < 16; ++i) { a[i] = bf_lo((unsigned)*(const LAS unsigned short*)(col + (32 * g + i) * SROW)); b[i] = bf_lo((unsigned)*(const LAS unsigned short*)(col + (32 * g + 16 + i) * SROW)); }
                pg8::u32x4 c0, c1; pg8::cvt_block6(a, b, c0, c1);
                pg8::st16(drow + 16 * g, c0); pg8::st16(drow + 64 + 16 * g, c1); }
        }
    }
    __syncthreads();
    const int gw = vcu * NWAVES + wave, NGW = G * NWAVES; (void)gw; (void)NGW;
    {
        const size_t nvec = (size_t)NTOK * DM / 8; const GAS f32x4* x4 = (const GAS f32x4*)P.in[0]; GAS v4u* o = (GAS v4u*)(ws + WS_XB);
        for (size_t i = (size_t)vcu * NTHR + tid; i < nvec; i += (size_t)G * NTHR) { const f32x4 a = x4[2 * i], b = x4[2 * i + 1];
            v4u w; w.x = pk2(a[0], a[1]); w.y = pk2(a[2], a[3]); w.z = pk2(b[0], b[1]); w.w = pk2(b[2], b[3]); pg8::st16((void*)(o + i), w); }
    }
    {
        float* ct = (float*)(ws + WS_COS); float* st = (float*)(ws + WS_SIN);
        for (int i = vcu * NTHR + tid; i < SEQ * 32; i += G * NTHR) { const int pos = i >> 5, j = i & 31;
            const float ang = (float)pos * P.inv_freq[j];
            const double rev = (double)ang * 0.15915494309189535; const float fr = (float)(rev - floor(rev));
            ct[i] = __builtin_amdgcn_cosf(fr); st[i] = __builtin_amdgcn_sinf(fr); }
    }
}

__device__ __forceinline__ int crow(int r, int hi) { return (r & 3) + 8 * (r >> 2) + 4 * hi; }
__device__ __forceinline__ void attn_phase(const Ptrs& P, LAS unsigned char* lds, int G, int tid, int lane, int wave) {
    constexpr int KS_STRIDE = 144, VT_STRIDE = 784, VT_OFF = 384 * KS_STRIDE;
    const bf16* qkv = (const bf16*)(P.ws + WS_QKV); bf16* O = (bf16*)(P.ws + WS_O); const float* sink = P.in[2];
    LAS unsigned char* Ks = lds + RING_OFF; LAS unsigned char* Vt = lds + RING_OFF + VT_OFF;
    const int r32 = lane & 31, hi = lane >> 5, g = wave >> 1, qhalf = wave & 1;
    for (int u = blockIdx.x; u < 4 * 64 * 4; u += G) {
        const int kvh = u & 3, blk = (u >> 2) & 63, b = u >> 8;
#pragma unroll
        for (int j = 0; j < 6; ++j) {
            const int id = tid + NTHR * j, row = id >> 3, pc = id & 7, kpos = (blk - 1) * 128 + row;
            v4u kv = (v4u){0u, 0u, 0u, 0u}, vv = (v4u){0u, 0u, 0u, 0u};
            if (kpos >= 0 && kpos < SEQ) { const bf16* src = qkv + (size_t)(b * SEQ + kpos) * NQKV + kvh * 64 + pc * 8; kv = *(const GAS v4u*)(src + 1024); vv = *(const GAS v4u*)(src + 1280); }
            *(LAS v4u*)(Ks + row * KS_STRIDE + pc * 16) = kv;
#pragma unroll
            for (int e = 0; e < 8; ++e) *(LAS unsigned short*)(Vt + (pc * 8 + e) * VT_STRIDE + row * 2) = (unsigned short)((vv[e >> 1] >> (16 * (e & 1))) & 0xffffu);
        }
        __syncthreads();
        const int head = kvh * 4 + g; const float sink_l2 = sink[head] * LOG2E;
#pragma unroll 1
        for (int qg = 0; qg < 2; ++qg) {
            const int ql0 = 64 * qhalf + 32 * qg, jt0 = 2 * qhalf + qg;
            const size_t tok = (size_t)b * SEQ + blk * 128 + ql0 + r32;
            bf16x8 qf[4];
#pragma unroll
            for (int s = 0; s < 4; ++s) qf[s] = *(const GAS bf16x8*)(qkv + tok * NQKV + head * 64 + 16 * s + 8 * hi);
            float m = sink_l2, l = (hi == 0) ? 1.f : 0.f;
            f32x16 o0 = {}, o1 = {};
#pragma unroll
            for (int c = 0; c < 3; ++c) {
                f32x16 S[3];
#pragma unroll
                for (int tt = 0; tt < 3; ++tt) {
                    const int jt = jt0 + 3 * c + tt;
                    const LAS unsigned char* kp = Ks + (32 * jt + r32) * KS_STRIDE + 16 * hi;
                    f32x16 a = {};
#pragma unroll
                    for (int s = 0; s < 4; ++s) { const bf16x8 kf = *(const LAS bf16x8*)(kp + 32 * s); a = __builtin_amdgcn_mfma_f32_32x32x16_bf16(kf, qf[s], a, 0, 0, 0); }
                    const int tau = 3 * c + tt, kpos0 = (blk - 1) * 128 + 32 * jt;
                    const bool tile_ok = (kpos0 >= 0) && (kpos0 < SEQ);
#pragma unroll
                    for (int r = 0; r < 16; ++r) { const int kk = crow(r, hi); bool ok = tile_ok; if (tau == 0) ok = ok && (kk >= r32); if (tau == 8) ok = ok && (kk <= r32); a[r] = ok ? a[r] : -INFINITY; }
                    S[tt] = a;
                }
                float cm = -INFINITY;
#pragma unroll
                for (int tt = 0; tt < 3; ++tt)
#pragma unroll
                    for (int r = 0; r < 16; ++r) cm = fmaxf(cm, S[tt][r]);
                cm = fmaxf(cm, __shfl_xor(cm, 32));
                if (__any(cm > m + 8.f)) { const float mn = fmaxf(m, cm); const float f = __builtin_amdgcn_exp2f(m - mn); l *= f; o0 *= f; o1 *= f; m = mn; }
                float ls = 0.f;
#pragma unroll
                for (int tt = 0; tt < 3; ++tt)
#pragma unroll
                    for (int r = 0; r < 16; ++r) { const float p = __builtin_amdgcn_exp2f(S[tt][r] - m); S[tt][r] = p; ls += p; }
                l += ls;
#pragma unroll
                for (int tt = 0; tt < 3; ++tt) {
                    const int jt = jt0 + 3 * c + tt;
#pragma unroll
                    for (int ks = 0; ks < 2; ++ks) {
                        v4u pw; pw.x = pk2(S[tt][8 * ks + 0], S[tt][8 * ks + 1]); pw.y = pk2(S[tt][8 * ks + 2], S[tt][8 * ks + 3]); pw.z = pk2(S[tt][8 * ks + 4], S[tt][8 * ks + 5]); pw.w = pk2(S[tt][8 * ks + 6], S[tt][8 * ks + 7]);
                        const bf16x8 pf = __builtin_bit_cast(bf16x8, pw);
                        const LAS unsigned char* vp = Vt + r32 * VT_STRIDE + (32 * jt + 16 * ks + 4 * hi) * 2;
                        { const v2u lo = *(const LAS v2u*)(vp), hi2 = *(const LAS v2u*)(vp + 16); const v4u vw = (v4u){lo.x, lo.y, hi2.x, hi2.y};
                          o0 = __builtin_amdgcn_mfma_f32_32x32x16_bf16(__builtin_bit_cast(bf16x8, vw), pf, o0, 0, 0, 0); }
                        { const v2u lo = *(const LAS v2u*)(vp + 32 * VT_STRIDE), hi2 = *(const LAS v2u*)(vp + 32 * VT_STRIDE + 16); const v4u vw = (v4u){lo.x, lo.y, hi2.x, hi2.y};
                          o1 = __builtin_amdgcn_mfma_f32_32x32x16_bf16(__builtin_bit_cast(bf16x8, vw), pf, o1, 0, 0, 0); }
                    }
                }
            }
            l += __shfl_xor(l, 32);
            const float inv = 1.f / l;
            bf16* op = O + tok * DM + head * 64 + 4 * hi;
#pragma unroll
            for (int r4 = 0; r4 < 4; ++r4) {
                v2u w; w.x = pk2(o0[4 * r4] * inv, o0[4 * r4 + 1] * inv); w.y = pk2(o0[4 * r4 + 2] * inv, o0[4 * r4 + 3] * inv); pg8::st8(op + 8 * r4, w);
                v2u w1; w1.x = pk2(o1[4 * r4] * inv, o1[4 * r4 + 1] * inv); w1.y = pk2(o1[4 * r4 + 2] * inv, o1[4 * r4 + 3] * inv); pg8::st8(op + 32 + 8 * r4, w1);
            }
        }
        __syncthreads();
    }
}

struct Row16 { float v[16]; };
__device__ __forceinline__ void ln_row(Row16& x, const Row16& gm, const Row16& bt) {
    float s = 0.f;
#pragma unroll
    for (int i = 0; i < 16; ++i) s += x.v[i];
    const float mean = wave_sum(s) * (1.f / DM); float q = 0.f;
#pragma unroll
    for (int i = 0; i < 16; ++i) { x.v[i] -= mean; q += x.v[i] * x.v[i]; }
    const float rstd = 1.0f / sqrtf(wave_sum(q) * (1.f / DM) + LN_EPS);
#pragma unroll
    for (int i = 0; i < 16; ++i) x.v[i] = x.v[i] * rstd * gm.v[i] + bt.v[i];
}
__device__ __forceinline__ void load_vec16(Row16& r, const float* p, int lane) {
#pragma unroll
    for (int j = 0; j < 2; ++j) { const f32x4 a = *(const GAS f32x4*)(p + 8 * lane + 512 * j), b = *(const GAS f32x4*)(p + 8 * lane + 512 * j + 4);
#pragma unroll
        for (int i = 0; i < 4; ++i) { r.v[8 * j + i] = a[i]; r.v[8 * j + 4 + i] = b[i]; } }
}
__device__ __forceinline__ void load_bf16row(Row16& r, const bf16* p, int lane) {
#pragma unroll
    for (int j = 0; j < 2; ++j) { const v4u w = *(const GAS v4u*)(p + 8 * lane + 512 * j);
        r.v[8 * j + 0] = bf_lo(w.x); r.v[8 * j + 1] = bf_hi(w.x); r.v[8 * j + 2] = bf_lo(w.y); r.v[8 * j + 3] = bf_hi(w.y);
        r.v[8 * j + 4] = bf_lo(w.z); r.v[8 * j + 5] = bf_hi(w.z); r.v[8 * j + 6] = bf_lo(w.w); r.v[8 * j + 7] = bf_hi(w.w); }
}
__device__ __forceinline__ void store_bf16row(const Row16& r, bf16* p, int lane) {
#pragma unroll
    for (int j = 0; j < 2; ++j) { v4u w; w.x = pk2(r.v[8 * j], r.v[8 * j + 1]); w.y = pk2(r.v[8 * j + 2], r.v[8 * j + 3]); w.z = pk2(r.v[8 * j + 4], r.v[8 * j + 5]); w.w = pk2(r.v[8 * j + 6], r.v[8 * j + 7]);
        pg8::st16(p + 8 * lane + 512 * j, w); }
}
__device__ __forceinline__ void ln_phase(const bf16* src, const float* g, const float* bta, bf16* dst, int vcu, int G, int lane, int wave) {
    Row16 gm, bt; load_vec16(gm, g, lane); load_vec16(bt, bta, lane);
    const int stride = G * NWAVES;
    for (int row0 = vcu * NWAVES + wave; row0 < NTOK; row0 += 4 * stride) {
        Row16 x[4];
#pragma unroll
        for (int j = 0; j < 4; ++j) { const int row = row0 + j * stride; if (row < NTOK) load_bf16row(x[j], src + (size_t)row * DM, lane); }
#pragma unroll
        for (int j = 0; j < 4; ++j) { const int row = row0 + j * stride; if (row < NTOK) { ln_row(x[j], gm, bt); store_bf16row(x[j], dst + (size_t)row * DM, lane); } }
    }
}
__device__ __forceinline__ void ln_router_phase(const Ptrs& P, LAS unsigned char* lds, const bf16* src, const float* g, const float* bta, bf16* dst, int G, int tid, int lane, int wave) {
    const float* router = P.in[15]; int* topi = (int*)(P.ws + WS_TOPI); float* gate = (float*)(P.ws + WS_GATE); int* wgcnt = (int*)(P.ws + WS_WGCNT);
    LAS int* hist = (LAS int*)(lds + RING_OFF);
    if (tid < 8) hist[tid] = 0;
    __syncthreads();
    const int tpw = (NTOK + G - 1) / G, t0 = blockIdx.x * tpw, t1 = (t0 + tpw < NTOK) ? t0 + tpw : NTOK;
    {
        Row16 gm, bt; load_vec16(gm, g, lane); load_vec16(bt, bta, lane);
        f32x4 rwa[16], rwb[16];
#pragma unroll
        for (int j = 0; j < 2; ++j)
#pragma unroll
            for (int i = 0; i < 8; ++i) { const float* rp = router + (size_t)(8 * lane + 512 * j + i) * 8; rwa[8 * j + i] = *(const GAS f32x4*)rp; rwb[8 * j + i] = *(const GAS f32x4*)(rp + 4); }
        int cnt[8];
#pragma unroll
        for (int e = 0; e < 8; ++e) cnt[e] = 0;
        Row16 xnext; if (t0 + wave < t1) load_bf16row(xnext, src + (size_t)(t0 + wave) * DM, lane);
        for (int row = t0 + wave; row < t1; row += NWAVES) {
            Row16 x = xnext; if (row + NWAVES < t1) load_bf16row(xnext, src + (size_t)(row + NWAVES) * DM, lane);
            ln_row(x, gm, bt);
            store_bf16row(x, dst + (size_t)row * X3_STRIDE, lane);
            float lg[8];
#pragma unroll
            for (int e = 0; e < 8; ++e) lg[e] = 0.f;
#pragma unroll
            for (int i = 0; i < 16; ++i) { const float xv = x.v[i]; const f32x4 a = rwa[i], b2 = rwb[i];
                lg[0] += xv * a[0]; lg[1] += xv * a[1]; lg[2] += xv * a[2]; lg[3] += xv * a[3]; lg[4] += xv * b2[0]; lg[5] += xv * b2[1]; lg[6] += xv * b2[2]; lg[7] += xv * b2[3]; }
#pragma unroll
            for (int e = 0; e < 8; ++e) lg[e] = wave_sum(lg[e]);
            int i1 = 0; float v1 = lg[0];
#pragma unroll
            for (int e = 1; e < 8; ++e) if (lg[e] > v1) { v1 = lg[e]; i1 = e; }
            int i2 = -1; float v2 = -INFINITY;
#pragma unroll
            for (int e = 0; e < 8; ++e) if (e != i1 && lg[e] > v2) { v2 = lg[e]; i2 = e; }
            const float e2 = expf(v2 - v1), g1 = 1.f / (1.f + e2), g2 = e2 / (1.f + e2);
            if (lane == 0) { topi[2 * row] = i1; topi[2 * row + 1] = i2; gate[2 * row] = g1; gate[2 * row + 1] = g2; }
#pragma unroll
            for (int e = 0; e < 8; ++e) cnt[e] += (i1 == e || i2 == e) ? 1 : 0;
        }
        if (lane == 0) {
#pragma unroll
            for (int e = 0; e < 8; ++e) atomicAdd((int*)(hist + e), cnt[e]);
        }
    }
    __syncthreads();
    if (tid < 8) wgcnt[blockIdx.x * 8 + tid] = hist[tid];
    __syncthreads();
}
__device__ __forceinline__ void route_phase(const Ptrs& P, LAS unsigned char* lds, int G, int tid, int lane, int wave) {
    const int* topi = (const int*)(P.ws + WS_TOPI); const int* wgcnt = (const int*)(P.ws + WS_WGCNT); int* posof = (int*)(P.ws + WS_POS);
    const bf16* x3 = (const bf16*)P.out; unsigned char* xs = P.ws + WS_XS;
    LAS int* tot = (LAS int*)(lds + RING_OFF); LAS int* bef = tot + 8; LAS int* base = tot + 16; LAS int* posl = tot + 64;
    LAS int* ts = (LAS int*)(lds + TAB_OFF);
    if (tid < 16) tot[tid] = 0;
    __syncthreads();
    { const int e = tid & 7; int a = 0, bsum = 0;
      for (int w = tid >> 3; w < G; w += NTHR / 8) { const int c = wgcnt[w * 8 + e]; a += c; if (w < (int)blockIdx.x) bsum += c; }
      atomicAdd((int*)(tot + e), a); atomicAdd((int*)(bef + e), bsum); }
    __syncthreads();
    if (tid == 0) { int t = 0;
        for (int e = 0; e < 8; ++e) { ts[e] = t; base[e] = t * 256 + bef[e]; t += (tot[e] + 255) >> 8; }
        ts[8] = t; }
    __syncthreads();
    const int tpw = (NTOK + G - 1) / G, t0 = blockIdx.x * tpw, t1 = (t0 + tpw < NTOK) ? t0 + tpw : NTOK, nq = 2 * (t1 - t0);
    if (wave == 0) {
        int bs[8];
#pragma unroll
        for (int e = 0; e < 8; ++e) bs[e] = base[e];
        for (int q0 = 0; q0 < nq; q0 += 64) {
            const int q = q0 + lane; const int myE = (q < nq) ? topi[2 * t0 + q] : -1; int pos = 0;
#pragma unroll
            for (int e = 0; e < 8; ++e) { const unsigned long long bal = __ballot(myE == e); const int below = __builtin_popcountll(bal & ((1ull << lane) - 1ull));
                if (myE == e) pos = bs[e] + below; bs[e] += __builtin_popcountll(bal); }
            if (q < nq) { posl[q] = pos; posof[2 * t0 + q] = pos; }
        }
    }
    __syncthreads();
    for (int q0 = 2 * wave; q0 < nq; q0 += 2 * NWAVES) {
        const int q = q0 + (lane >> 5), b = lane & 31;
        if (q < nq) { const int pos = posl[q]; const bf16* sp = x3 + (size_t)(t0 + (q >> 1)) * X3_STRIDE + 32 * b;
            v4u w[4];
#pragma unroll
            for (int i = 0; i < 4; ++i) w[i] = *(const GAS v4u*)(sp + 8 * i);
            pg8::f32x16 fa, fb;
#pragma unroll
            for (int i = 0; i < 2; ++i) { fa[8 * i + 0] = bf_lo(w[i].x); fa[8 * i + 1] = bf_hi(w[i].x); fa[8 * i + 2] = bf_lo(w[i].y); fa[8 * i + 3] = bf_hi(w[i].y); fa[8 * i + 4] = bf_lo(w[i].z); fa[8 * i + 5] = bf_hi(w[i].z); fa[8 * i + 6] = bf_lo(w[i].w); fa[8 * i + 7] = bf_hi(w[i].w);
                fb[8 * i + 0] = bf_lo(w[2 + i].x); fb[8 * i + 1] = bf_hi(w[2 + i].x); fb[8 * i + 2] = bf_lo(w[2 + i].y); fb[8 * i + 3] = bf_hi(w[2 + i].y); fb[8 * i + 4] = bf_lo(w[2 + i].z); fb[8 * i + 5] = bf_hi(w[2 + i].z); fb[8 * i + 6] = bf_lo(w[2 + i].w); fb[8 * i + 7] = bf_hi(w[2 + i].w); }
            pg8::u32x4 c0, c1; pg8::cvt_block6(fa, fb, c0, c1);
            unsigned char* d = xs + (size_t)pos * DM + 128 * (b >> 2) + 16 * (b & 3);
            pg8::st16(d, c0); pg8::st16(d + 64, c1); }
    }
    if (blockIdx.x < 8) { const int e = blockIdx.x; const int r0 = ts[e] * 256 + tot[e], r1 = ts[e + 1] * 256;
        for (int r = r0 + wave; r < r1; r += NWAVES) *(GAS v4u*)(xs + (size_t)r * DM + 16 * lane) = (v4u){0u, 0u, 0u, 0u}; }
    __syncthreads();
}
__device__ __forceinline__ void combine_phase(const Ptrs& P, const float* g, const float* bta, int vcu, int G, int lane, int wave) {
    const bf16* x3 = (const bf16*)P.out; const bf16* ys = (const bf16*)(P.ws + WS_YS); const int* posof = (const int*)(P.ws + WS_POS); const float* gate = (const float*)(P.ws + WS_GATE);
    Row16 gm, bt; load_vec16(gm, g, lane); load_vec16(bt, bta, lane);
    const int stride = G * NWAVES;
    for (int row0 = vcu * NWAVES + wave; row0 < NTOK; row0 += 2 * stride) {
        Row16 x[2], y1[2], y2[2]; float g1[2], g2[2];
#pragma unroll
        for (int j = 0; j < 2; ++j) { const int row = row0 + j * stride; if (row < NTOK) {
            const int p1 = posof[2 * row], p2 = posof[2 * row + 1]; g1[j] = gate[2 * row]; g2[j] = gate[2 * row + 1];
            load_bf16row(x[j], x3 + (size_t)row * X3_STRIDE, lane); load_bf16row(y1[j], ys + (size_t)p1 * DM, lane); load_bf16row(y2[j], ys + (size_t)p2 * DM, lane); } }
#pragma unroll
        for (int j = 0; j < 2; ++j) { const int row = row0 + j * stride; if (row < NTOK) {
#pragma unroll
            for (int i = 0; i < 16; ++i) x[j].v[i] = DN_ALPHA * x[j].v[i] + (g1[j] * y1[j].v[i] + g2[j] * y2[j].v[i]);
            ln_row(x[j], gm, bt);
            float* o = P.out + (size_t)row * DM;
#pragma unroll
            for (int jj = 0; jj < 2; ++jj) { *(GAS f32x4*)(o + 8 * lane + 512 * jj) = (f32x4){x[j].v[8 * jj], x[j].v[8 * jj + 1], x[j].v[8 * jj + 2], x[j].v[8 * jj + 3]}; *(GAS f32x4*)(o + 8 * lane + 512 * jj + 4) = (f32x4){x[j].v[8 * jj + 4], x[j].v[8 * jj + 5], x[j].v[8 * jj + 6], x[j].v[8 * jj + 7]}; }
        } }
    }
}

__device__ __forceinline__ void conv_phase(const Ptrs& P, LAS unsigned char* lds, int G, int tid, int lane, int wave) {
    const bf16* gin = (const bf16*)(P.ws + WS_G1); bf16* cout = (bf16*)(P.ws + WS_C1);
    const float* dw = P.in[6]; const float* dwb = P.in[7]; const float* ng = P.in[8]; const float* nb = P.in[9];
    LAS float* wl = (LAS float*)(lds + RING_OFF);
    LAS float* red = (LAS float*)(lds + RING_OFF + 31 * 1024 * 4);
    for (int i = tid; i < 31 * 256; i += NTHR) ((LAS f32x4*)wl)[i] = ((const GAS f32x4*)dw)[i];
    __syncthreads();
    const int tg = wave >> 2, c0 = 4 * ((wave & 3) * 64 + lane);
    const f32x4 bias = *(const GAS f32x4*)(dwb + c0);
    for (int tile = blockIdx.x; tile < NTOK / 16; tile += G) {
        const int tok0 = tile * 16 + 8 * tg, s0 = (tok0 & (SEQ - 1)) - 15;
        f32x4 acc[8], W[8];
#pragma unroll
        for (int o = 0; o < 8; ++o) { acc[o] = bias; W[o] = (f32x4){0.f, 0.f, 0.f, 0.f}; }
#define CONV_LOAD(dst, ib) do { _Pragma("unroll") for (int j = 0; j < 8; ++j) { const int i = (ib) + j, sq = s0 + i; dst[j] = (v2u){0u, 0u}; if (i < 38 && sq >= 0 && sq < SEQ) dst[j] = *(const GAS v2u*)(gin + (size_t)(tok0 - 15 + i) * DM + c0); } } while (0)
#define CONV_BLOCK(ib, STATIC) do { v2u xc[8]; \
            _Pragma("unroll") for (int j = 0; j < 8; ++j) xc[j] = xn[j]; \
            if ((ib) + 8 < 40) CONV_LOAD(xn, (ib) + 8);            \
            _Pragma("unroll") for (int j = 0; j < 8; ++j) { const int i = (ib) + j; \
                if (STATIC) { if (i <= 30) W[j] = *(const LAS f32x4*)(wl + i * 1024 + c0); } else W[j] = (i <= 30) ? *(const LAS f32x4*)(wl + i * 1024 + c0) : (f32x4){0.f, 0.f, 0.f, 0.f}; \
                if (!(STATIC) || i < 38) { const f32x4 x = (f32x4){bf_lo(xc[j].x), bf_hi(xc[j].x), bf_lo(xc[j].y), bf_hi(xc[j].y)}; \
                    _Pragma("unroll") for (int o = 0; o < 8; ++o) { const int k = i - o; if (!(STATIC) || (k >= 0 && k <= 30)) acc[o] += x * W[(j - o) & 7]; } } } } while (0)
        v2u xn[8]; CONV_LOAD(xn, 0);
        CONV_BLOCK(0, true);
#pragma unroll 1
        for (int ib = 8; ib < 32; ib += 8) CONV_BLOCK(ib, false);
        CONV_BLOCK(32, true);
#undef CONV_BLOCK
#undef CONV_LOAD
#pragma unroll
        for (int o = 0; o < 8; ++o) { const f32x4 a = acc[o]; float s1 = (a[0] + a[1]) + (a[2] + a[3]), s2 = (a[0] * a[0] + a[1] * a[1]) + (a[2] * a[2] + a[3] * a[3]);
            s1 = wave_sum(s1); s2 = wave_sum(s2);
            if (lane == 0) { red[(wave * 8 + o) * 2] = s1; red[(wave * 8 + o) * 2 + 1] = s2; } }
        __syncthreads();
        const f32x4 gg = *(const GAS f32x4*)(ng + c0), gb = *(const GAS f32x4*)(nb + c0);
#pragma unroll
        for (int o = 0; o < 8; ++o) {
            float s1 = 0.f, s2 = 0.f;
#pragma unroll
            for (int w = 0; w < 4; ++w) { s1 += red[((4 * tg + w) * 8 + o) * 2]; s2 += red[((4 * tg + w) * 8 + o) * 2 + 1]; }
            const float mean = s1 * (1.f / DM); float var = s2 * (1.f / DM) - mean * mean; var = var < 0.f ? 0.f : var; const float rstd = __builtin_amdgcn_rsqf(var + LN_EPS);
            f32x4 t = (acc[o] - mean) * rstd * gg + gb;
#pragma unroll
            for (int c = 0; c < 4; ++c) t[c] = t[c] * pg8::sigmoidf_fast(t[c]);
            v2u w; w.x = pk2(t[0], t[1]); w.y = pk2(t[2], t[3]);
            pg8::st8(cout + (size_t)(tok0 + o) * DM + c0, w); }
        __syncthreads();
    }
}

constexpr int NPH = 15;
struct Args { const float* in[23]; float* out; unsigned char* ws; int ph_lo, ph_hi, li, pad; float inv_freq[32]; };
__global__ void __launch_bounds__(NTHR, 2) fwd_kernel(Args args) {
    extern __shared__ __attribute__((aligned(16))) unsigned char lds_raw[];
    LAS unsigned char* lds = (LAS unsigned char*)lds_raw;
    const int tid = threadIdx.x, lane = tid & 63, wave = __builtin_amdgcn_readfirstlane(tid >> 6);
    const int G = gridDim.x; const int bx = blockIdx.x; const int vcu = (G % 8 == 0) ? (bx % 8) * (G / 8) + bx / 8 : bx;
    Ptrs P;
#pragma unroll
    for (int i = 0; i < 23; ++i) P.in[i] = args.in[i];
    P.out = args.out; P.ws = args.ws; P.inv_freq = args.inv_freq;
    unsigned char* ws = args.ws;
    gu32* ctl = (gu32*)(ws + WS_CTL);
    for (int u = tid; u < (LDS_BYTES - LDSCTL_OFF) / 4; u += NTHR) ((LAS unsigned*)(lds + LDSCTL_OFF))[u] = 0u;
    __syncthreads();
    volatile LAS unsigned* MISC = (volatile LAS unsigned*)(lds + MISC_OFF);
    XcdBarrier bar = xcd_barrier_post((unsigned*)(ctl + CW_BAR) + args.li * XCD_BAR_WORDS, MISC + 8);
    const int lo = args.ph_lo, hi = args.ph_hi;
#define IN(k) (lo <= (k) && (k) < hi)
#define SEAM(k) do { if (IN(k) && IN((k) + 1)) xcd_barrier(bar); } while (0)
    const float* ln_mix_g = P.in[19]; const float* ln_mix_b = P.in[20]; const float* ln_ffn_g = P.in[21]; const float* ln_ffn_b = P.in[22];
    pg8::bf16_t* vbuf = (pg8::bf16_t*)P.out;

    if (IN(0)) { p0_prologue(P, lds, vcu, G, tid, lane, wave); } SEAM(0);
    if (IN(1)) {
        pg8::Gemm g{(const pg8::bf16_t*)(ws + WS_XB), (const pg8::bf16_t*)(ws + WS_WQKV), 1024, 0, 0};
        pg8::StaticOrder S; S.init(NTOK / 256, NQKV / 256, G, bx);
        pg8::EpiQKV E{(pg8::bf16_t*)(ws + WS_QKV), (const float*)(ws + WS_COS), (const float*)(ws + WS_SIN), 0.125f * LOG2E};
        pg8::gemm_phase<0>(lds + RING_OFF, g, S, E);
    } SEAM(1);
    if (IN(2)) { attn_phase(P, lds, G, tid, lane, wave); } SEAM(2);
    if (IN(3)) {
        pg8::Gemm g{(const pg8::bf16_t*)(ws + WS_O), (const pg8::bf16_t*)(ws + WS_WO), 1024, 0, 0};
        pg8::StaticOrder S; S.init(NTOK / 256, DM / 256, G, bx);
        pg8::EpiResBf16<false> E{vbuf, (const void*)P.in[0], nullptr, DN_ALPHA};
        pg8::gemm_phase<0>(lds + RING_OFF, g, S, E);
    } SEAM(3);
    if (IN(4)) { ln_phase(vbuf, ln_mix_g, ln_mix_b, (bf16*)(ws + WS_X1B), vcu, G, lane, wave); } SEAM(4);
    if (IN(5)) {
        pg8::Gemm g{(const pg8::bf16_t*)(ws + WS_X1B), (const pg8::bf16_t*)(ws + WS_WGU), 1024, 0, 0};
        pg8::StaticOrder S; S.init(NTOK / 256, 2 * FF / 256, G, bx);
        pg8::EpiGated<0> E{(pg8::bf16_t*)(ws + WS_H), FF, nullptr, 0, HBLK};
#if PROBE_SPLIT
        S.i1 = 7; pg8::gemm_phase<0>(lds + RING_OFF, g, S, E); xcd_barrier(bar); S.i0 = 7; S.i1 = 1 << 30;
#endif
        pg8::gemm_phase<0>(lds + RING_OFF, g, S, E);
    } SEAM(5);
    if (IN(6)) {
        pg8::Gemm g{(const pg8::bf16_t*)(ws + WS_H), (const pg8::bf16_t*)(ws + WS_WDN), FF, 0, HBLK};
        pg8::StaticOrder S; S.init(NTOK / 256, DM / 256, G, bx);
        pg8::EpiResBf16<true> E{vbuf, (const void*)(ws + WS_X1B), nullptr, DN_ALPHA};
        pg8::gemm_phase<0>(lds + RING_OFF, g, S, E);
    } SEAM(6);
    if (IN(7)) { ln_phase(vbuf, ln_ffn_g, ln_ffn_b, (bf16*)(ws + WS_X2B), vcu, G, lane, wave); } SEAM(7);
    if (IN(8)) {
        pg8::Gemm g{(const pg8::bf16_t*)(ws + WS_X2B), (const pg8::bf16_t*)(ws + WS_WPW1), 1024, 0, 0};
        pg8::StaticOrder S; S.init(NTOK / 256, 2048 / 256, G, bx);
        pg8::EpiGated<1> E{(pg8::bf16_t*)(ws + WS_G1), DM, P.in[5], 1024, 0};
        pg8::gemm_phase<0>(lds + RING_OFF, g, S, E);
    } SEAM(8);
    if (IN(9)) { conv_phase(P, lds, G, tid, lane, wave); } SEAM(9);
    if (IN(10)) {
        pg8::Gemm g{(const pg8::bf16_t*)(ws + WS_C1), (const pg8::bf16_t*)(ws + WS_WPW2), 1024, 0, 0};
        pg8::StaticOrder S; S.init(NTOK / 256, DM / 256, G, bx);
        pg8::EpiResBf16<true> E{(pg8::bf16_t*)(ws + WS_VPW2), (const void*)(ws + WS_X2B), P.in[11], DN_ALPHA};
        pg8::gemm_phase<0>(lds + RING_OFF, g, S, E);
    } SEAM(10);
    if (IN(11)) { ln_router_phase(P, lds, (const bf16*)(ws + WS_VPW2), ln_mix_g + DM, ln_mix_b + DM, (bf16*)P.out, G, tid, lane, wave); } SEAM(11);
    if (IN(12)) { route_phase(P, lds, G, tid, lane, wave); } SEAM(12);
    if (IN(13)) {
        LAS int* tsl = (LAS int*)(lds + TAB_OFF);
        if (!IN(12)) {
            __syncthreads();
            LAS int* tot = (LAS int*)(lds + RING_OFF);
            if (tid < 8) tot[tid] = 0;
            __syncthreads();
            { const int e = tid & 7; int a = 0; const int* wgcnt = (const int*)(ws + WS_WGCNT);
              for (int w = tid >> 3; w < G; w += NTHR / 8) a += wgcnt[w * 8 + e];
              atomicAdd((int*)(tot + e), a); }
            __syncthreads();
            if (tid == 0) { int t = 0; for (int e = 0; e < 8; ++e) { tsl[e] = t; t += (tot[e] + 255) >> 8; } tsl[8] = t; }
            __syncthreads();
        }
        int ts[9];
#pragma unroll
        for (int e = 0; e < 9; ++e) ts[e] = __builtin_amdgcn_readfirstlane(tsl[e]);
        const int ntile = ts[8];
        for (int t0 = 0; t0 < ntile; t0 += MOE_CHUNK_TILES) {
            const int nT = (ntile - t0) < MOE_CHUNK_TILES ? (ntile - t0) : MOE_CHUNK_TILES;
            {
                pg8::Gemm g{(const pg8::bf16_t*)(ws + WS_XS + (size_t)t0 * 256 * DM), (const pg8::bf16_t*)(ws + WS_MWGU), 512, (size_t)7168 * 1024, 0};
                pg8::MoeOrder S; S.so.init(nT, 2 * FF / 256, G, bx); S.t0 = t0;
#pragma unroll
                for (int e = 0; e < 9; ++e) S.ts[e] = ts[e];
                pg8::EpiGated8 E{ws + WS_HC, FF, 1.f, SH8};
                pg8::gemm_phase<2>(lds + RING_OFF, g, S, E);
            }
            xcd_barrier(bar);
            {
                pg8::Gemm g{(const pg8::bf16_t*)(ws + WS_HC), (const pg8::bf16_t*)(ws + WS_MWDN), FF / 2, (size_t)1024 * FF, 1};
                pg8::MoeOrder S; S.so.init(nT, DM / 256, G, bx); S.t0 = t0;
#pragma unroll
                for (int e = 0; e < 9; ++e) S.ts[e] = ts[e];
                pg8::EpiPlainBf16 E{(pg8::bf16_t*)(ws + WS_YS) + (size_t)t0 * 256 * DM, DM, 1.f / (SH8 * SD8)};
                pg8::gemm_phase<1>(lds + RING_OFF, g, S, E);
            }
            if (t0 + MOE_CHUNK_TILES < ntile) xcd_barrier(bar);
        }
    } SEAM(13);
    if (IN(14)) { combine_phase(P, ln_ffn_g + DM, ln_ffn_b + DM, vcu, G, lane, wave); }
#undef IN
#undef SEAM
}

extern "C" void kernel_launch(void* const* d_in, const int* in_sizes, int n_in, void* d_out, int out_size, void* d_ws, size_t ws_size, hipStream_t stream) {
    static int grid = 0;
    if (grid == 0) {
        if (n_in != 23 || in_sizes[0] != NTOK * DM || out_size != NTOK * DM || ws_size < WS_END) { fprintf(stderr, "kernel_launch: unexpected shapes (n_in %d, ws %zu)\n", n_in, ws_size); grid = -1; return; }
        int dev = 0, cus = 0, per_cu = 0;
        if (hipGetDevice(&dev) != hipSuccess || hipDeviceGetAttribute(&cus, hipDeviceAttributeMultiprocessorCount, dev) != hipSuccess) { grid = -1; return; }
        if (hipFuncSetAttribute((const void*)fwd_kernel, hipFuncAttributeMaxDynamicSharedMemorySize, LDS_BYTES) != hipSuccess) { grid = -1; return; }
        if (hipOccupancyMaxActiveBlocksPerMultiprocessor(&per_cu, (const void*)fwd_kernel, NTHR, LDS_BYTES) != hipSuccess || per_cu < 1) fprintf(stderr, "kernel_launch: occupancy query says %d\n", per_cu);
        (void)hipGetLastError();
        grid = cus;
    }
    if (grid < 0) return;
    if (hipMemsetAsync((char*)d_ws + WS_CTL, 0, CTL_ZERO_BYTES, stream) != hipSuccess) return;
    Args a{};
    for (int i = 0; i < 23; ++i) a.in[i] = (const float*)d_in[i];
    a.out = (float*)d_out; a.ws = (unsigned char*)d_ws;
    for (int j = 0; j < 32; ++j) a.inv_freq[j] = (float)pow(10000.0, -(double)j / 32.0);
    constexpr int NL = MK_N_LAUNCHES;
    static_assert(NL == 1 || NL == NPH, "MK_N_LAUNCHES is 1 or NPH");
#ifdef PROBE_PRE_HI
    a.ph_lo = PROBE_PRE_LO; a.ph_hi = PROBE_PRE_HI; a.li = 20; hipLaunchKernelGGL(fwd_kernel, dim3(grid), dim3(NTHR), LDS_BYTES, stream, a);
#endif
    for (int li = 0; li < NL; ++li) {
        a.ph_lo = (NL == 1) ? 0 : li; a.ph_hi = (NL == 1) ? NPH : li + 1; a.li = li;
        hipLaunchKernelGGL(fwd_kernel, dim3(grid), dim3(NTHR), LDS_BYTES, stream, a);
    }
}
```

```cpp
#include <hip/hip_runtime.h>
#include <cstdio>
#include <cstdint>
#include <cmath>

#ifndef PROBE_SPLIT
#define PROBE_SPLIT 0
#endif
#ifndef HBLK
#define HBLK 1
#endif
#ifndef MK_N_LAUNCHES
#define MK_N_LAUNCHES 1
#endif

namespace pg8 {
#define PG8_LAS __attribute__((address_space(3)))
typedef unsigned short bf16_t;
typedef short bf16x8 __attribute__((ext_vector_type(8)));
typedef float f32x4 __attribute__((ext_vector_type(4)));
typedef float f32x2 __attribute__((ext_vector_type(2)));
typedef unsigned u32x4 __attribute__((ext_vector_type(4)));
typedef unsigned u32x2 __attribute__((ext_vector_type(2)));
constexpr int BM = 256, BK = 64, HALF = 128, HTB = HALF * BK * 2, STAGE_BYTES = 8 * HTB, NXCD = 8, WGM = 8;

__host__ __device__ __forceinline__ int lds_byte(int r, int c) { const int st = (r >> 4) * 2 + (c >> 5), rr = r & 15, cc = c & 31, ob = rr * 64 + cc * 2; return st * 1024 + (ob ^ (((ob >> 9) & 1) << 5)); }
__host__ __device__ __forceinline__ void stage_rc(int b, int& R, int& C) { const int st = b / 1024, sb = b % 1024, swz = sb ^ (((sb >> 9) & 1) << 5); R = (st >> 1) * 16 + swz / 64; C = (st & 1) * 32 + (swz % 64) / 2; }
__host__ __device__ __forceinline__ int perm32(int rho) { const int n = rho >> 4, i = rho & 15; return 8 * (i >> 2) + 4 * n + (i & 3); }

struct Unit { int pm, pn, e; unsigned ka, kb; };
__host__ __device__ __forceinline__ size_t blk_off8(int row, int kb, int Kb) { return ((size_t)(row >> 8) * (Kb >> 7) + (kb >> 7)) * 32768 + (row & 255) * 128 + (kb & 127); }
struct Gemm { const bf16_t* A; const bf16_t* Bt; int K; size_t estride; int ablk; int Kp; };

struct StaticOrder {
    int nM, nN, nwg, G, c; int i0 = 0, i1 = 1 << 30;
    __device__ __forceinline__ void init(int nM_, int nN_, int G_, int c_) { nM = nM_; nN = nN_; nwg = nM * nN; G = G_; c = c_; }
    __device__ __forceinline__ bool next(int i, Unit& u) const {
        if (i + i0 >= i1) return false; const long L = (long)(i + i0) * G + c; if (L >= nwg) return false;
        int wgid = (int)L; { const int q = nwg / NXCD, r = nwg % NXCD, xcd = wgid % NXCD, off = wgid / NXCD; wgid = (xcd < r ? xcd * (q + 1) : r * (q + 1) + (xcd - r) * q) + off; }
        const int nig = WGM * nN, gid = wgid / nig, fm = gid * WGM, gsz = (nM - fm) < WGM ? (nM - fm) : WGM;
        u.pm = fm + ((wgid % nig) % gsz); u.pn = (wgid % nig) / gsz; u.e = 0; u.ka = 0u; u.kb = 0u; return true;
    }
};
struct MoeOrder {
    StaticOrder so; int t0; int ts[9];
    __device__ __forceinline__ bool next(int i, Unit& u) const {
        if (!so.next(i, u)) return false;
        const int gt = t0 + u.pm; int e = 0;
#pragma unroll
        for (int j = 1; j < 8; ++j) e += (gt >= ts[j]) ? 1 : 0;
        u.e = e; return true;
    }
};

struct TailOrder {
    int nunits, G, c; int ts[9];
    __device__ __forceinline__ bool next(int i, Unit& u) const {
        const int v = i * G + c; if (v >= nunits) return false;
        u.pm = 256 + v / 28; const int r = v % 28; u.pn = r / 7; const int ks = r % 7;
        u.ka = (unsigned)ks * 4u * 32768u; u.kb = (unsigned)ks * 512u;
        int e = 0;
#pragma unroll
        for (int j = 1; j < 8; ++j) e += (u.pm >= ts[j]) ? 1 : 0;
        u.e = e; return true;
    }
};
__device__ __forceinline__ unsigned cvt_pk_bf16(float lo, float hi) { unsigned r; asm volatile("v_cvt_pk_bf16_f32 %0, %1, %2" : "=v"(r) : "v"(lo), "v"(hi)); return r; }

typedef int i32x8 __attribute__((ext_vector_type(8)));
typedef int i32x4 __attribute__((ext_vector_type(4)));
__device__ __forceinline__ i32x8 cat8(bf16x8 a, bf16x8 b) { const i32x4 x = __builtin_bit_cast(i32x4, a), y = __builtin_bit_cast(i32x4, b); return (i32x8){x[0], x[1], x[2], x[3], y[0], y[1], y[2], y[3]}; }
__device__ __forceinline__ const char* addp(const char* base, unsigned off) {
    const unsigned long long b = (unsigned long long)base; const unsigned blo = (unsigned)b, bhi = (unsigned)(b >> 32); unsigned lo, hi;
    asm volatile("v_add_co_u32 %0, vcc, %2, %3\n\tv_addc_co_u32 %1, vcc, %4, 0, vcc" : "=&v"(lo), "=v"(hi) : "s"(blo), "v"(off), "s"(bhi) : "vcc");
    return (const char*)(((unsigned long long)hi << 32) | lo);
}
__device__ __forceinline__ float clamp448(float v) { return __builtin_amdgcn_fmed3f(v, -448.f, 448.f); }
__device__ __forceinline__ unsigned pk4_fp8(float a, float b, float c, float d) {
    int r = __builtin_amdgcn_cvt_pk_fp8_f32(clamp448(a), clamp448(b), 0, false); r = __builtin_amdgcn_cvt_pk_fp8_f32(clamp448(c), clamp448(d), r, true); return (unsigned)r; }
typedef float f32x16 __attribute__((ext_vector_type(16)));
typedef unsigned u32x6 __attribute__((ext_vector_type(6)));
__device__ __forceinline__ void cvt_block6(const f32x16& a, const f32x16& b, u32x4& c0, u32x4& c1) {
    float mx = 0.f;
#pragma unroll
    for (int i = 0; i < 16; ++i) mx = __builtin_fmaxf(mx, __builtin_fmaxf(__builtin_fabsf(a[i]), __builtin_fabsf(b[i])));
    int e = (int)((__float_as_uint(mx * 1.0666667f) >> 23) & 0xffu) - 127 - 2;
    e = e < -100 ? -100 : (e > 100 ? 100 : e);
    const float inv = __uint_as_float((unsigned)(127 - e) << 23);
    f32x16 x, y;
#pragma unroll
    for (int i = 0; i < 16; ++i) { x[i] = __builtin_fminf(__builtin_fmaxf(a[i] * inv, -7.5f), 7.5f); y[i] = __builtin_fminf(__builtin_fmaxf(b[i] * inv, -7.5f), 7.5f); }
    const u32x6 r = __builtin_amdgcn_cvt_scalef32_2xpk16_fp6_f32(x, y, 1.0f);
    c0 = (u32x4){r[0], r[1], r[2], r[3]}; c1 = (u32x4){r[4], r[5], (unsigned)(e + 127), 0u};
}
#ifndef WT_STORES
#define WT_STORES 0
#endif
__device__ __forceinline__ void st16(void* p, u32x4 v) {
#if WT_STORES
    asm volatile("global_store_dwordx4 %0, %1, off sc1" :: "v"(p), "v"(v) : "memory");
#else
    *(u32x4*)p = v;
#endif
}
__device__ __forceinline__ void st8(void* p, u32x2 v) {
#if WT_STORES
    asm volatile("global_store_dwordx2 %0, %1, off sc1" :: "v"(p), "v"(v) : "memory");
#else
    *(u32x2*)p = v;
#endif
}

struct EpiQKV {
    static constexpr bool PERM = true;
    bf16_t* O; const float* ctab; const float* stab; float qscale;
    __device__ __forceinline__ void operator()(const f32x4 (&acc)[2][2][4][2], const Unit& u, int wr, int wc, int fr, int fq) const {
        const int row0 = u.pm * BM + wr * 64 + fr, col0 = u.pn * BM + wc * 32 + 8 * fq;
        const int j0 = 16 * (wc & 1) + 4 * fq;
        const bool rope = u.pn < 5; const float sc = u.pn < 4 ? qscale : 1.f;
#pragma unroll
        for (int ai = 0; ai < 2; ++ai)
#pragma unroll
            for (int m = 0; m < 4; ++m) {
                const int row = row0 + ai * HALF + m * 16; const int pos = row & 8191;
                f32x4 cs = (f32x4){1.f, 1.f, 1.f, 1.f}, sn = (f32x4){0.f, 0.f, 0.f, 0.f};
                if (rope) { cs = *(const f32x4*)(ctab + pos * 32 + j0); sn = *(const f32x4*)(stab + pos * 32 + j0); }
                bf16_t* rowp = O + (size_t)row * 1536 + col0;
#pragma unroll
                for (int bj = 0; bj < 2; ++bj) {
                    const f32x4 v0 = acc[ai][bj][m][0], v1 = acc[ai][bj][m][1];
                    const f32x4 o0 = (v0 * cs - v1 * sn) * sc, o1 = (v1 * cs + v0 * sn) * sc;
                    u32x4 w; w.x = cvt_pk_bf16(o0[0], o0[1]); w.y = cvt_pk_bf16(o0[2], o0[3]); w.z = cvt_pk_bf16(o1[0], o1[1]); w.w = cvt_pk_bf16(o1[2], o1[3]);
                    st16(rowp + bj * HALF, w); }
            }
    }
};
__device__ __forceinline__ float sigmoidf_fast(float x) { return __builtin_amdgcn_rcpf(1.f + __builtin_amdgcn_exp2f(-1.4426950408889634f * x)); }
__device__ __forceinline__ f32x4 sigmoid4(f32x4 x, float k) {
    const f32x4 z = x * k; f32x4 e;
#pragma unroll
    for (int i = 0; i < 4; ++i) e[i] = __builtin_amdgcn_exp2f(z[i]);
    const f32x4 d = e + 1.f; f32x4 r;
#pragma unroll
    for (int i = 0; i < 4; ++i) r[i] = __builtin_amdgcn_rcpf(d[i]);
    return r;
}
template <int MODE> struct EpiGated {
    static constexpr bool PERM = true;
    bf16_t* O; int ldo; const float* bias; int bias_half; int oblk;
    __device__ __forceinline__ void operator()(const f32x4 (&acc)[2][2][4][2], const Unit& u, int wr, int wc, int fr, int fq) const {
        const int row0 = u.pm * BM + wr * 64 + fr, col0 = u.pn * HALF + wc * 16 + 4 * fq;
        f32x4 ba[2], bb[2];
#pragma unroll
        for (int bj = 0; bj < 2; ++bj) { if (MODE == 1) { ba[bj] = *(const f32x4*)(bias + col0 + bj * 64); bb[bj] = *(const f32x4*)(bias + bias_half + col0 + bj * 64); } else { ba[bj] = (f32x4){0.f, 0.f, 0.f, 0.f}; bb[bj] = ba[bj]; } }
#pragma unroll
        for (int ai = 0; ai < 2; ++ai)
#pragma unroll
            for (int m = 0; m < 4; ++m) {
                const int row = row0 + ai * HALF + m * 16;
                bf16_t* rowp = oblk ? O + ((size_t)(row >> 8) * (ldo >> 6) + (col0 >> 6)) * 16384 + (row & 255) * 64 + (col0 & 63) : O + (size_t)row * ldo + col0;
                const int bjs = oblk ? 16384 : 64;
#pragma unroll
                for (int bj = 0; bj < 2; ++bj) {
                    f32x4 o;
                    if constexpr (MODE == 0) { const f32x4 a = acc[ai][bj][m][0], b = acc[ai][bj][m][1]; o = (a * b) * sigmoid4(a, -1.4426950408889634f); }
                    else { const f32x4 a = acc[ai][bj][m][0] + ba[bj], b = acc[ai][bj][m][1] + bb[bj]; o = a * sigmoid4(b, -1.4426950408889634f); }
                    u32x2 w; w.x = cvt_pk_bf16(o[0], o[1]); w.y = cvt_pk_bf16(o[2], o[3]);
                    st8(rowp + bj * bjs, w); }
            }
    }
};
struct EpiGated8 {
    static constexpr bool PERM = true;
    unsigned char* O; int ldo; float inv, hs;
    __device__ __forceinline__ void operator()(const f32x4 (&acc)[2][2][4][2], const Unit& u, int wr, int wc, int fr, int fq) const {
        const int row0 = u.pm * BM + wr * 64 + fr, col0 = u.pn * HALF + wc * 32 + 8 * fq;
#pragma unroll
        for (int ai = 0; ai < 2; ++ai)
#pragma unroll
            for (int m = 0; m < 4; ++m) {
                unsigned char* rowp = O + blk_off8(row0 + ai * HALF + m * 16, col0, ldo); u32x2 w;
#pragma unroll
                for (int bj = 0; bj < 2; ++bj) { const f32x4 a = acc[ai][bj][m][0], b = acc[ai][bj][m][1];
                    const f32x4 o = ((a * b) * (inv * inv * hs)) * sigmoid4(a, -1.4426950408889634f * inv);
                    const unsigned p = pk4_fp8(o[0], o[1], o[2], o[3]); if (bj == 0) w.x = p; else w.y = p; }
                st8(rowp, w);
            }
    }
};
template <bool RESB> struct EpiResBf16 {
    static constexpr bool PERM = true;
    bf16_t* O; const void* res; const float* bias; float alpha;
    __device__ __forceinline__ void operator()(const f32x4 (&acc)[2][2][4][2], const Unit& u, int wr, int wc, int fr, int fq) const {
        const int row0 = u.pm * BM + wr * 64 + fr, col0 = u.pn * BM + wc * 32 + 8 * fq;
        f32x4 bv[2][2];
#pragma unroll
        for (int bj = 0; bj < 2; ++bj)
#pragma unroll
            for (int n = 0; n < 2; ++n) bv[bj][n] = bias ? *(const f32x4*)(bias + col0 + bj * HALF + 4 * n) : (f32x4){0.f, 0.f, 0.f, 0.f};
        if constexpr (RESB) {
#pragma unroll
            for (int ai = 0; ai < 2; ++ai) {
                u32x4 rw[4][2];
#pragma unroll
                for (int m = 0; m < 4; ++m)
#pragma unroll
                    for (int bj = 0; bj < 2; ++bj) rw[m][bj] = *(const u32x4*)((const bf16_t*)res + (size_t)(row0 + ai * HALF + m * 16) * 1024 + col0 + bj * HALF);
#pragma unroll
                for (int m = 0; m < 4; ++m) { const size_t off = (size_t)(row0 + ai * HALF + m * 16) * 1024 + col0;
#pragma unroll
                    for (int bj = 0; bj < 2; ++bj) { const u32x4 w0 = rw[m][bj];
                        const f32x4 r0 = (f32x4){__uint_as_float(w0.x << 16), __uint_as_float(w0.x & 0xffff0000u), __uint_as_float(w0.y << 16), __uint_as_float(w0.y & 0xffff0000u)};
                        const f32x4 r1 = (f32x4){__uint_as_float(w0.z << 16), __uint_as_float(w0.z & 0xffff0000u), __uint_as_float(w0.w << 16), __uint_as_float(w0.w & 0xffff0000u)};
                        const f32x4 v0 = r0 * alpha + acc[ai][bj][m][0] + bv[bj][0], v1 = r1 * alpha + acc[ai][bj][m][1] + bv[bj][1];
                        u32x4 w; w.x = cvt_pk_bf16(v0[0], v0[1]); w.y = cvt_pk_bf16(v0[2], v0[3]); w.z = cvt_pk_bf16(v1[0], v1[1]); w.w = cvt_pk_bf16(v1[2], v1[3]);
                        st16(O + off + bj * HALF, w); } }
            }
        } else {
#pragma unroll
            for (int ai = 0; ai < 2; ++ai)
#pragma unroll
              for (int mp = 0; mp < 4; mp += 2) {
                f32x4 r0[2][2], r1[2][2];
#pragma unroll
                for (int mm = 0; mm < 2; ++mm)
#pragma unroll
                    for (int bj = 0; bj < 2; ++bj) { const float* rp = (const float*)res + (size_t)(row0 + ai * HALF + (mp + mm) * 16) * 1024 + col0 + bj * HALF; r0[mm][bj] = *(const f32x4*)rp; r1[mm][bj] = *(const f32x4*)(rp + 4); }
#pragma unroll
                for (int mm = 0; mm < 2; ++mm) { const int m = mp + mm; const size_t off = (size_t)(row0 + ai * HALF + m * 16) * 1024 + col0;
#pragma unroll
                    for (int bj = 0; bj < 2; ++bj) {
                        const f32x4 v0 = r0[mm][bj] * alpha + acc[ai][bj][m][0] + bv[bj][0], v1 = r1[mm][bj] * alpha + acc[ai][bj][m][1] + bv[bj][1];
                        u32x4 w; w.x = cvt_pk_bf16(v0[0], v0[1]); w.y = cvt_pk_bf16(v0[2], v0[3]); w.z = cvt_pk_bf16(v1[0], v1[1]); w.w = cvt_pk_bf16(v1[2], v1[3]);
                        st16(O + off + bj * HALF, w); } }
              }
        }
    }
};
struct EpiTailF32 {
    static constexpr bool PERM = false;
    float* P; float sc;
    __device__ __forceinline__ void operator()(const f32x4 (&acc)[2][2][4][2], const Unit& u, int wr, int wc, int fr, int fq) const {
        const int row0 = (u.pm - 256) * BM + wr * 64 + fr, col0 = u.pn * BM + wc * 32 + 4 * fq; const int ks = (int)(u.kb >> 9);
        float* base = P + (size_t)ks * 2048 * 1024;
#pragma unroll
        for (int ai = 0; ai < 2; ++ai)
#pragma unroll
            for (int m = 0; m < 4; ++m) { float* rowp = base + (size_t)(row0 + ai * HALF + m * 16) * 1024 + col0;
#pragma unroll
                for (int bj = 0; bj < 2; ++bj)
#pragma unroll
                    for (int n = 0; n < 2; ++n) *(f32x4*)(rowp + bj * HALF + 16 * n) = acc[ai][bj][m][n] * sc; }
    }
};
struct EpiPlainBf16 {
    static constexpr bool PERM = true;
    bf16_t* O; int ldo; float sc;
    __device__ __forceinline__ void operator()(const f32x4 (&acc)[2][2][4][2], const Unit& u, int wr, int wc, int fr, int fq) const {
        const int row0 = u.pm * BM + wr * 64 + fr, col0 = u.pn * BM + wc * 32 + 8 * fq;
#pragma unroll
        for (int ai = 0; ai < 2; ++ai)
#pragma unroll
            for (int m = 0; m < 4; ++m) { bf16_t* rowp = O + (size_t)(row0 + ai * HALF + m * 16) * ldo + col0;
#pragma unroll
                for (int bj = 0; bj < 2; ++bj) { const f32x4 v0 = acc[ai][bj][m][0] * sc, v1 = acc[ai][bj][m][1] * sc;
                    u32x4 w; w.x = cvt_pk_bf16(v0[0], v0[1]); w.y = cvt_pk_bf16(v0[2], v0[3]); w.z = cvt_pk_bf16(v1[0], v1[1]); w.w = cvt_pk_bf16(v1[2], v1[3]);
                    st16(rowp + bj * HALF, w); } }
    }
};

template <int MODE, class Epi, class Sched>
__device__ __forceinline__ void gemm_phase(PG8_LAS unsigned char* lds, const Gemm g, const Sched& S, const Epi& E) {
    const int tid = threadIdx.x, wid = __builtin_amdgcn_readfirstlane(tid >> 6), lane = tid & 63, wr = wid >> 2, wc = wid & 3, fr = lane & 15, fq = lane >> 4;
    constexpr bool F8 = (MODE != 0);
    const int K = g.Kp ? g.Kp : g.K, nt = g.K / BK;
    unsigned voffA[2], voffB[2];
#pragma unroll
    for (int i = 0; i < 2; ++i) { int R, C; stage_rc(tid * 16 + i * 8192, R, C); const int Rb = Epi::PERM ? ((R & ~31) + perm32(R & 31)) : R;
        voffA[i] = g.ablk ? (unsigned)(R * 128 + C * 2) : (unsigned)(R * K + C) * 2u; voffB[i] = (unsigned)(Rb * K + C) * 2u; }
    const unsigned kstep = (unsigned)(BK * 2);
    const unsigned hstep = (unsigned)HALF * (unsigned)K * 2u;
    const unsigned tstep = 2u * hstep;
    const unsigned kstepA = g.ablk ? 32768u : kstep, hstepA = g.ablk ? 16384u : hstep;
    const unsigned ldsw = (unsigned)wid * 1024u;
    const int aoff = lds_byte(wr * 64 + fr, fq * 8), boff = lds_byte(wc * 32 + fr, fq * 8);
    __amdgpu_buffer_rsrc_t rsA = __builtin_amdgcn_make_buffer_rsrc((void*)g.A, 0, 0x7fffffff, 0x00020000), rsB = __builtin_amdgcn_make_buffer_rsrc((void*)g.Bt, 0, 0x7fffffff, 0x00020000);
#define PG8_SA(b, h) (((b) * 2 + (h)) * HTB)
#define PG8_SB(b, h) ((4 + (b) * 2 + (h)) * HTB)
#define PG8_STAGE(bufoff, isA, uoff, voff) do { _Pragma("unroll") for (int _i = 0; _i < 2; ++_i) { \
        if constexpr (F8) __builtin_amdgcn_raw_ptr_buffer_load_lds((isA) ? rsA : rsB, (PG8_LAS void*)(lds + (bufoff) + ldsw + _i * 8192), 16, (voff)[_i], (uoff), 0, 0); \
        else __builtin_amdgcn_global_load_lds((const unsigned*)((const char*)((isA) ? (const void*)g.A : (const void*)g.Bt) + (size_t)(uoff) + (voff)[_i]), (PG8_LAS unsigned*)(lds + (bufoff) + ldsw + _i * 8192), 16, 0, 0); } } while (0)
#define PG8_LDA(dst, b, h) do { _Pragma("unroll") for (int m = 0; m < 4; ++m) _Pragma("unroll") for (int k = 0; k < 2; ++k) dst[m][k] = *(const PG8_LAS bf16x8*)(lds + PG8_SA(b, h) + aoff + m * 2048 + k * 1024); } while (0)
#define PG8_LDB(dst, b, h) do { _Pragma("unroll") for (int n = 0; n < 2; ++n) _Pragma("unroll") for (int k = 0; k < 2; ++k) dst[n][k] = *(const PG8_LAS bf16x8*)(lds + PG8_SB(b, h) + boff + n * 2048 + k * 1024); } while (0)
#define PG8_MMA(ai, bj, At, Bt) do { __builtin_amdgcn_s_setprio(1); _Pragma("unroll") for (int m = 0; m < 4; ++m) _Pragma("unroll") for (int n = 0; n < 2; ++n) { \
        if constexpr (MODE == 1) { acc[ai][bj][m][n] = __builtin_amdgcn_mfma_scale_f32_16x16x128_f8f6f4(cat8(Bt[n][0], Bt[n][1]), cat8(At[m][0], At[m][1]), acc[ai][bj][m][n], 0, 0, 0, 0x7f7f7f7f, 0, 0x7f7f7f7f); } \
        else if constexpr (MODE == 2) { const i32x8 b8_ = cat8(Bt[n][0], Bt[n][1]), a8_ = cat8(At[m][0], At[m][1]); acc[ai][bj][m][n] = __builtin_amdgcn_mfma_scale_f32_16x16x128_f8f6f4(b8_, a8_, acc[ai][bj][m][n], 2, 2, 0, b8_[6], 0, a8_[6]); } \
        else { _Pragma("unroll") for (int k = 0; k < 2; ++k) acc[ai][bj][m][n] = __builtin_amdgcn_mfma_f32_16x16x32_bf16(Bt[n][k], At[m][k], acc[ai][bj][m][n], 0, 0, 0); } } __builtin_amdgcn_s_setprio(0); } while (0)
#define PG8_WAIT_V(n) asm volatile("s_waitcnt vmcnt(" #n ")" ::: "memory")
#define PG8_WAIT_L(n) asm volatile("s_waitcnt lgkmcnt(" #n ")" ::: "memory")
#define PG8_BAR __builtin_amdgcn_s_barrier()
#define PG8_SCHED __builtin_amdgcn_sched_barrier(0)
    Unit cur, nxt; int ui = 0;
    if (!S.next(0, cur)) return;
    f32x4 acc[2][2][4][2];
#pragma unroll
    for (int a = 0; a < 2; ++a)
#pragma unroll
        for (int b = 0; b < 2; ++b)
#pragma unroll
            for (int m = 0; m < 4; ++m)
#pragma unroll
                for (int n = 0; n < 2; ++n) acc[a][b][m][n] = (f32x4){0.f, 0.f, 0.f, 0.f};
    bf16x8 At[4][2], B0[2][2], B1[2][2];
    unsigned cA = (unsigned)cur.pm * tstep + cur.ka, cB = (unsigned)cur.e * (unsigned)g.estride + (unsigned)cur.pn * tstep + cur.kb;
    PG8_STAGE(PG8_SB(0, 0), false, cB, voffB); PG8_STAGE(PG8_SB(0, 1), false, cB + hstep, voffB); PG8_STAGE(PG8_SA(0, 0), true, cA, voffA); PG8_STAGE(PG8_SA(0, 1), true, cA + hstepA, voffA);
    if (wr == 1) PG8_BAR;
    PG8_WAIT_V(2); PG8_BAR;
    PG8_STAGE(PG8_SB(1, 0), false, cB + kstep, voffB); PG8_STAGE(PG8_SA(1, 0), true, cA + kstepA, voffA); PG8_STAGE(PG8_SB(1, 1), false, cB + hstep + kstep, voffB);
    PG8_WAIT_V(6); PG8_BAR;
    for (;;) {
        const bool has_next = S.next(ui + 1, nxt);
        const unsigned nA = has_next ? (unsigned)nxt.pm * tstep + nxt.ka : cA, nB = has_next ? (unsigned)nxt.e * (unsigned)g.estride + (unsigned)nxt.pn * tstep + nxt.kb : cB;
        asm volatile(".p2align 7");
#pragma unroll 1
        for (int t = 0; t < nt; t += 2) {
            const bool last = (t == nt - 2);
            const unsigned a1 = cA + (unsigned)(t + 1) * kstepA;
            const unsigned a2 = last ? nA : cA + (unsigned)(t + 2) * kstepA, b2 = last ? nB : cB + (unsigned)(t + 2) * kstep;
            const unsigned a3 = a2 + kstepA, b3 = b2 + kstep;
            PG8_LDB(B0, 0, 0); PG8_LDB(B1, 0, 1); PG8_SCHED; PG8_LDA(At, 0, 0); PG8_STAGE(PG8_SA(1, 1), true, a1 + hstepA, voffA);
            PG8_WAIT_V(8); PG8_WAIT_L(0); PG8_BAR; PG8_MMA(0, 0, At, B0); PG8_MMA(0, 1, At, B1); PG8_BAR; PG8_SCHED;
            PG8_LDA(At, 0, 1); PG8_STAGE(PG8_SB(0, 0), false, b2, voffB); PG8_STAGE(PG8_SB(0, 1), false, b2 + hstep, voffB); PG8_STAGE(PG8_SA(0, 0), true, a2, voffA);
            PG8_WAIT_V(8); PG8_WAIT_L(0); PG8_BAR; PG8_MMA(1, 0, At, B0); PG8_MMA(1, 1, At, B1); PG8_BAR; PG8_SCHED;
            PG8_LDB(B0, 1, 0); PG8_LDB(B1, 1, 1); PG8_SCHED; PG8_LDA(At, 1, 0); PG8_STAGE(PG8_SA(0, 1), true, a2 + hstepA, voffA);
            PG8_WAIT_V(8); PG8_WAIT_L(0); PG8_BAR; PG8_MMA(0, 0, At, B0); PG8_MMA(0, 1, At, B1); PG8_BAR; PG8_SCHED;
            PG8_LDA(At, 1, 1); PG8_STAGE(PG8_SB(1, 0), false, b3, voffB); PG8_STAGE(PG8_SB(1, 1), false, b3 + hstep, voffB); PG8_STAGE(PG8_SA(1, 0), true, a3, voffA);
            PG8_WAIT_V(8); PG8_WAIT_L(0); PG8_BAR; PG8_MMA(1, 0, At, B0); PG8_MMA(1, 1, At, B1); PG8_BAR; PG8_SCHED;
        }
        if (wr == 0) PG8_BAR;
        E(acc, cur, wr, wc, fr, fq);
        if (!has_next) break;
#pragma unroll
        for (int a = 0; a < 2; ++a)
#pragma unroll
            for (int b = 0; b < 2; ++b)
#pragma unroll
                for (int m = 0; m < 4; ++m)
#pragma unroll
                    for (int n = 0; n < 2; ++n) acc[a][b][m][n] = (f32x4){0.f, 0.f, 0.f, 0.f};
        cur = nxt; cA = nA; cB = nB; ++ui;
        if (wr == 1) PG8_BAR;
    }
    PG8_WAIT_V(0);
    PG8_BAR;
#undef PG8_SA
#undef PG8_SB
#undef PG8_STAGE
#undef PG8_LDA
#undef PG8_LDB
#undef PG8_MMA
#undef PG8_WAIT_V
#undef PG8_WAIT_L
#undef PG8_BAR
#undef PG8_SCHED
}
}

constexpr int NWAVES = 8, NTHR = 512;
constexpr int NTOK = 32768, SEQ = 8192, DM = 1024, NQKV = 1536, FF = 3584, NE = 8, NHEAD = 16, NKV = 4;
constexpr float LN_EPS = 1e-5f;
constexpr float DN_ALPHA = 1.4142135623730951f;
constexpr float LOG2E = 1.4426950408889634f;
constexpr int MOE_CHUNK_TILES = 264;
constexpr float SX8 = 4.f, SW8 = 128.f, SH8 = 8.f, SD8 = 512.f;
constexpr int MAX_TILES = 264;

constexpr size_t MiB = 1u << 20;
constexpr size_t WS_CTL = 0, CTL_ZERO_BYTES = 1 * MiB;
constexpr size_t WS_COS = 1 * MiB, WS_SIN = 2 * MiB;
constexpr size_t WS_TOPI = 3 * MiB, WS_GATE = WS_TOPI + 256 * 1024, WS_POS = WS_GATE + 256 * 1024, WS_WGCNT = WS_POS + 256 * 1024;
constexpr size_t WS_MWGU = 8 * MiB, WS_MWDN = 64 * MiB;
constexpr size_t WS_WQKV = 92 * MiB, WS_WO = 95 * MiB, WS_WPW1 = 97 * MiB, WS_WPW2 = 101 * MiB, WS_WGU = 103 * MiB, WS_WDN = 117 * MiB;
constexpr size_t WS_ACT = 124 * MiB;
constexpr size_t WS_XB = WS_ACT, WS_QKV = WS_ACT + 64 * MiB, WS_O = WS_ACT + 160 * MiB, WS_X1B = WS_ACT + 224 * MiB, WS_H = WS_ACT;
constexpr size_t WS_X2B = WS_ACT, WS_G1 = WS_ACT + 64 * MiB, WS_C1 = WS_ACT + 128 * MiB, WS_VPW2 = WS_ACT + 192 * MiB;
constexpr size_t WS_XS = 92 * MiB, WS_HC = 158 * MiB, WS_YS = 389 * MiB;
constexpr size_t WS_END = 521 * MiB;
constexpr size_t WS_TAILP = WS_XS;
static_assert(WS_TAILP + (size_t)7 * 2048 * 1024 * 4 <= WS_HC, "tail partials fit in the xs buffer");
constexpr int X3_STRIDE = 2048;
static_assert(WS_XS + (size_t)MAX_TILES * 256 * DM <= WS_HC && WS_HC + (size_t)MOE_CHUNK_TILES * 256 * FF <= WS_YS && WS_YS + (size_t)MAX_TILES * 256 * DM * 2 <= WS_END, "d_ws map (MoE)");
static_assert(WS_H + (size_t)NTOK * FF * 2 <= WS_X1B && WS_VPW2 + (size_t)NTOK * DM * 2 <= WS_END && WS_WDN + (size_t)DM * FF * 2 <= WS_ACT, "d_ws map");
constexpr int CW_TMO = 0, CW_CODE = 1, CW_BAR = 4096, CW_ITEM = 2048, CW_XCH = 2048 + 64;

constexpr int RING_OFF = 0, RING_BYTES = 131072;
constexpr int LDSCTL_OFF = RING_BYTES, MISC_OFF = LDSCTL_OFF + 320, TAB_OFF = LDSCTL_OFF + 1024;
constexpr int LDS_BYTES = 147456;

#define GAS __attribute__((address_space(1)))
#define LAS __attribute__((address_space(3)))
typedef unsigned short bf16;
typedef unsigned v4u __attribute__((ext_vector_type(4)));
typedef unsigned v2u __attribute__((ext_vector_type(2)));
typedef float f32x4 __attribute__((ext_vector_type(4)));
typedef float f32x16 __attribute__((ext_vector_type(16)));
typedef short bf16x8 __attribute__((ext_vector_type(8)));
typedef short s16x4 __attribute__((ext_vector_type(4)));
typedef float f32x2v __attribute__((ext_vector_type(2)));
typedef GAS unsigned gu32;
#define RLX_AGENT __ATOMIC_RELAXED, __HIP_MEMORY_SCOPE_AGENT
#define LDS_WAIT() asm volatile("s_waitcnt lgkmcnt(0)" ::: "memory")
#define VM_WAIT() asm volatile("s_waitcnt vmcnt(0)" ::: "memory")
__device__ __forceinline__ unsigned pk2(float lo, float hi) { return pg8::cvt_pk_bf16(lo, hi); }
__device__ __forceinline__ float bf_lo(unsigned w) { return __uint_as_float(w << 16); }
__device__ __forceinline__ float bf_hi(unsigned w) { return __uint_as_float(w & 0xffff0000u); }

#define XB_TMO      128
#define XB_XCNT(j)  (256  + 64 * (j))
#define XB_XSUB(j)  (1280 + 64 * (j))
#define XB_XGEN(j)  (2304 + 64 * (j))
#define XB_TOP      3328
#define XB_TOPGEN   3392
#define XCD_BAR_WORDS 3456
#define XB_SPIN_CAP (1u << 18)
__device__ __forceinline__ unsigned xb_ld(unsigned* p)              { return __hip_atomic_load(p, __ATOMIC_RELAXED, __HIP_MEMORY_SCOPE_AGENT); }
__device__ __forceinline__ unsigned xb_add(unsigned* p, unsigned v) { return __hip_atomic_fetch_add(p, v, __ATOMIC_RELAXED, __HIP_MEMORY_SCOPE_AGENT); }
__device__ __forceinline__ unsigned xb_xcc_id() { return (unsigned)__builtin_amdgcn_s_getreg((3 << 11) | 20) & 0xFu; }
#define XB_SPIN(cond, bar) do { unsigned _sp = 0; while (cond) { __builtin_amdgcn_s_sleep(1); \
    if ((++_sp & 255u) == 0u) { if (xb_ld(&(bar)[XB_TMO])) break; if (_sp > XB_SPIN_CAP) { atomicAdd(&(bar)[XB_TMO], 1u); break; } } } } while (0)
struct XcdBarrier { unsigned* bar; unsigned x; volatile LAS unsigned* st; };
__device__ __forceinline__ XcdBarrier xcd_barrier_post(unsigned* bar, volatile LAS unsigned* st) {
    XcdBarrier b; b.bar = bar; b.x = xb_xcc_id(); b.st = st;
    if (threadIdx.x == 0) (void)xb_add(&bar[XB_XCNT(b.x)], 1u);
    return b;
}
__device__ __forceinline__ void xcd_barrier_complete(unsigned* bar, unsigned x, unsigned& nloc, unsigned& nx) {
    const unsigned G = gridDim.x * gridDim.y * gridDim.z;
    unsigned sum, cnt, mine, sp = 0u;
    for (;;) {
        sum = 0u; cnt = 0u; mine = 0u;
#pragma unroll
        for (unsigned j = 0; j < 16; ++j) { const unsigned c = xb_ld(&bar[XB_XCNT(j)]); sum += c; cnt += (c > 0u) ? 1u : 0u; mine = (j == x) ? c : mine; }
        if (sum == G) break;
        __builtin_amdgcn_s_sleep(1);
        if ((++sp & 255u) == 0u) { if (xb_ld(&bar[XB_TMO])) break; if (sp > XB_SPIN_CAP) { atomicAdd(&bar[XB_TMO], 1u); break; } }
    }
    nloc = mine > 0u ? mine : 1u; nx = cnt > 0u ? cnt : 1u;
}
__device__ __forceinline__ void xcd_barrier(const XcdBarrier& b) {
    asm volatile("s_waitcnt vmcnt(0)" ::: "memory");
    __syncthreads();
    if (threadIdx.x == 0) {
        unsigned* bar = b.bar;
        __builtin_amdgcn_s_waitcnt(0);
        unsigned nloc = b.st[0], nx = b.st[1];
        if (nloc == 0u) { xcd_barrier_complete(bar, b.x, nloc, nx); b.st[0] = nloc; b.st[1] = nx; }
        const unsigned old = xb_add(&bar[XB_XSUB(b.x)], 1u);
        const unsigned gen = old / nloc;
        if (old + 1u == (gen + 1u) * nloc) {
            __builtin_amdgcn_fence(__ATOMIC_RELEASE, "agent");
            asm volatile("s_waitcnt vmcnt(0)" ::: "memory");
            const unsigned og = xb_add(&bar[XB_TOP], 1u);
            const unsigned tg = og / nx;
            if (og + 1u == (tg + 1u) * nx) xb_add(&bar[XB_TOPGEN], 1u);
            else XB_SPIN(xb_ld(&bar[XB_TOPGEN]) == tg, bar);
            __builtin_amdgcn_fence(__ATOMIC_ACQUIRE, "agent");
            xb_add(&bar[XB_XGEN(b.x)], 1u);
            asm volatile("s_waitcnt vmcnt(0)" ::: "memory");
        } else {
            XB_SPIN(xb_ld(&bar[XB_XGEN(b.x)]) == gen, bar);
            __builtin_amdgcn_fence(__ATOMIC_ACQUIRE, "agent");
            asm volatile("s_waitcnt vmcnt(0)" ::: "memory");
        }
    }
    __syncthreads();
}

#define DPP_ADD(v, ctrl, row_mask) ((v) + __builtin_bit_cast(float, __builtin_amdgcn_update_dpp(0, __builtin_bit_cast(int, (v)), (ctrl), (row_mask), 0xF, false)))
__device__ __forceinline__ float wave_sum(float v) {
    v = DPP_ADD(v, 0x111, 0xF);
    v = DPP_ADD(v, 0x112, 0xF);
    v = DPP_ADD(v, 0x114, 0xF);
    v = DPP_ADD(v, 0x118, 0xF);
    v = DPP_ADD(v, 0x142, 0xA);
    v = DPP_ADD(v, 0x143, 0xC);
    return __builtin_bit_cast(float, __builtin_amdgcn_readlane(__builtin_bit_cast(int, v), 63));
}

__device__ __forceinline__ float swapadd32(float a, float b) { auto rr = __builtin_amdgcn_permlane32_swap(__float_as_uint(a), __float_as_uint(b), false, false); return __uint_as_float(rr[0]) + __uint_as_float(rr[1]); }
__device__ __forceinline__ float swapadd16(float a, float b) { auto rr = __builtin_amdgcn_permlane16_swap(__float_as_uint(a), __float_as_uint(b), false, false); return __uint_as_float(rr[0]) + __uint_as_float(rr[1]); }
__device__ __forceinline__ void wave_sum8(const float (&v)[8], float (&out)[8]) {
    const float m0 = swapadd32(v[0], v[4]), m1 = swapadd32(v[1], v[5]), m2 = swapadd32(v[2], v[6]), m3 = swapadd32(v[3], v[7]);
    float n0 = swapadd16(m0, m2), n1 = swapadd16(m1, m3);
    n0 = DPP_ADD(n0, 0x111, 0xF); n1 = DPP_ADD(n1, 0x111, 0xF);
    n0 = DPP_ADD(n0, 0x112, 0xF); n1 = DPP_ADD(n1, 0x112, 0xF);
    n0 = DPP_ADD(n0, 0x114, 0xF); n1 = DPP_ADD(n1, 0x114, 0xF);
    n0 = DPP_ADD(n0, 0x118, 0xF); n1 = DPP_ADD(n1, 0x118, 0xF);
    const int i0 = __builtin_bit_cast(int, n0), i1 = __builtin_bit_cast(int, n1);
    out[0] = __builtin_bit_cast(float, __builtin_amdgcn_readlane(i0, 15)); out[2] = __builtin_bit_cast(float, __builtin_amdgcn_readlane(i0, 31));
    out[4] = __builtin_bit_cast(float, __builtin_amdgcn_readlane(i0, 47)); out[6] = __builtin_bit_cast(float, __builtin_amdgcn_readlane(i0, 63));
    out[1] = __builtin_bit_cast(float, __builtin_amdgcn_readlane(i1, 15)); out[3] = __builtin_bit_cast(float, __builtin_amdgcn_readlane(i1, 31));
    out[5] = __builtin_bit_cast(float, __builtin_amdgcn_readlane(i1, 47)); out[7] = __builtin_bit_cast(float, __builtin_amdgcn_readlane(i1, 63));
}

struct Ptrs {
    const float* in[23]; float* out; unsigned char* ws; const float* inv_freq;
};

__device__ __forceinline__ int map_row(int kind, int n) {
    if (kind == 1) { if (n >= 1280) return n; const int d = n & 63; return (n & ~63) + 8 * ((d & 31) >> 2) + 4 * (d >> 5) + (d & 3); }
    if (kind == 2) return 8 * (n >> 2) + (n & 3);
    if (kind == 3) return 8 * (n >> 2) + 4 + (n & 3);
    if (kind == 4) { const int f = n & 1023; return 8 * (f >> 2) + 4 * (n >> 10) + (f & 3); }
    return n;
}
__device__ __forceinline__ void tr_item(const float* W, int N, int K, int k0, int n0, bf16* dst, int kind, LAS unsigned char* scr, int lane) {
    f32x4 v[16];
    const int c4 = lane & 15, kr = lane >> 4;
#pragma unroll
    for (int j = 0; j < 16; ++j) v[j] = *(const GAS f32x4*)(W + (size_t)(k0 + kr + 4 * j) * N + n0 + 4 * c4);
#pragma unroll
    for (int j = 0; j < 16; ++j) { v2u w; w.x = pk2(v[j][0], v[j][1]); w.y = pk2(v[j][2], v[j][3]); *(LAS v2u*)(scr + (kr + 4 * j) * 136 + c4 * 8) = w; }
    LDS_WAIT(); asm volatile("" ::: "memory");
    const int c = lane & 7;
#pragma unroll
    for (int j = 0; j < 8; ++j) {
        const int n = 8 * j + (lane >> 3); const LAS unsigned char* s = scr + (8 * c) * 136 + 2 * n;
        unsigned h[8];
#pragma unroll
        for (int i = 0; i < 8; ++i) h[i] = *(const LAS unsigned short*)(s + i * 136);
        v4u o; o.x = h[0] | (h[1] << 16); o.y = h[2] | (h[3] << 16); o.z = h[4] | (h[5] << 16); o.w = h[6] | (h[7] << 16);
        pg8::st16(dst + (size_t)map_row(kind, n0 + n) * K + k0 + 8 * c, o);
    }
    LDS_WAIT(); asm volatile("" ::: "memory");
}
__device__ __forceinline__ int map_row8(int which, int f) { return 256 * (f >> 7) + 128 * ((f >> 2) & 1) + 32 * ((f & 127) >> 5) + 8 * ((f >> 3) & 3) + 4 * which + (f & 3); }
__device__ __forceinline__ void tr_item8(const float* W, int N, int K, int k0, int n0, unsigned char* dst, int which, float scale, LAS unsigned char* scr, int lane) {
    f32x4 v[16];
    const int c4 = lane & 15, kr = lane >> 4;
#pragma unroll
    for (int j = 0; j < 16; ++j) v[j] = *(const GAS f32x4*)(W + (size_t)(k0 + kr + 4 * j) * N + n0 + 4 * c4);
#pragma unroll
    for (int j = 0; j < 16; ++j) *(LAS unsigned*)(scr + (kr + 4 * j) * 68 + c4 * 4) = pg8::pk4_fp8(v[j][0] * scale, v[j][1] * scale, v[j][2] * scale, v[j][3] * scale);
    LDS_WAIT(); asm volatile("" ::: "memory");
    const int c = lane & 3;
#pragma unroll
    for (int j = 0; j < 4; ++j) {
        const int n = 16 * j + (lane >> 2); const LAS unsigned char* sp = scr + (16 * c) * 68 + n;
        unsigned h[16];
#pragma unroll
        for (int i = 0; i < 16; ++i) h[i] = *(const LAS unsigned char*)(sp + i * 68);
        v4u o;
        o.x = h[0] | (h[1] << 8) | (h[2] << 16) | (h[3] << 24); o.y = h[4] | (h[5] << 8) | (h[6] << 16) | (h[7] << 24);
        o.z = h[8] | (h[9] << 8) | (h[10] << 16) | (h[11] << 24); o.w = h[12] | (h[13] << 8) | (h[14] << 16) | (h[15] << 24);
        const int drow = which < 0 ? (n0 + n) : map_row8(which, n0 + n);
        pg8::st16(dst + (size_t)drow * K + k0 + 16 * c, o);
    }
    LDS_WAIT(); asm volatile("" ::: "memory");
}
__device__ __forceinline__ void tr_item6(const float* W, int N, int K, int k0, int n0, unsigned char* dst, int which, LAS unsigned char* scr, int lane) {
    LAS float* sf = (LAS float*)scr;
    { const int c4 = lane & 7, kr = lane >> 3;
#pragma unroll
      for (int j = 0; j < 16; ++j) { const f32x4 v = *(const GAS f32x4*)(W + (size_t)(k0 + kr + 8 * j) * N + n0 + 4 * c4); *(LAS f32x4*)(sf + (kr + 8 * j) * 32 + 4 * c4) = v; } }
    LDS_WAIT(); asm volatile("" ::: "memory");
    const int n = lane & 31, half = lane >> 5;
    unsigned char* drow = dst + (size_t)map_row8(which, n0 + n) * K + k0;
#pragma unroll
    for (int blk = 0; blk < 2; ++blk) {
        const int kb = 64 * half + 32 * blk, g = 2 * half + blk;
        pg8::f32x16 a, b;
#pragma unroll
        for (int i = 0; i < 16; ++i) { a[i] = sf[(kb + i) * 32 + n]; b[i] = sf[(kb + 16 + i) * 32 + n]; }
        pg8::u32x4 c0, c1; pg8::cvt_block6(a, b, c0, c1);
        pg8::st16(drow + 16 * g, c0); pg8::st16(drow + 64 + 16 * g, c1);
    }
    LDS_WAIT(); asm volatile("" ::: "memory");
}
constexpr int I_QKV = 8 * 6, I_WO = 8 * 4, I_PW1 = 8 * 8, I_PW2 = 8 * 4, I_G = 8 * 14, I_DN = 28 * 4;
constexpr int IB0 = 0, IB1 = IB0 + I_QKV, IB2 = IB1 + I_WO, IB3 = IB2 + I_PW1, IB4 = IB3 + I_PW2, IB5 = IB4 + I_G, IB6 = IB5 + I_G, IB7 = IB6 + I_DN, IB8 = IB7 + 8 * I_G, IB9 = IB8 + 8 * I_G, IB10 = IB9 + 8 * I_DN;
constexpr int IT_DENSE = IB7, IT_ALL = IB10, IT_P0 = IB1;
template <bool MOE>
__device__ __forceinline__ void weight_item(const Ptrs& P, LAS unsigned char* scr, int it, int tid, int lane, int wave) {
    unsigned char* ws = P.ws;
    constexpr int SROW = 520;
    const float* W; int N, K, r; int mode;
    unsigned char* dst;
    if constexpr (!MOE) {
        if (it < IB1)      { r = it - IB0; W = P.in[1];  K = 1024; N = 1536; mode = 1; dst = ws + WS_WQKV; }
        else if (it < IB2) { r = it - IB1; W = P.in[3];  K = 1024; N = 1024; mode = 0; dst = ws + WS_WO; }
        else if (it < IB3) { r = it - IB2; W = P.in[4];  K = 1024; N = 2048; mode = 4; dst = ws + WS_WPW1; }
        else if (it < IB4) { r = it - IB3; W = P.in[10]; K = 1024; N = 1024; mode = 0; dst = ws + WS_WPW2; }
        else if (it < IB5) { r = it - IB4; W = P.in[12]; K = 1024; N = 3584; mode = 2; dst = ws + WS_WGU; }
        else if (it < IB6) { r = it - IB5; W = P.in[13]; K = 1024; N = 3584; mode = 3; dst = ws + WS_WGU; }
        else               { r = it - IB6; W = P.in[14]; K = 3584; N = 1024; mode = 0; dst = ws + WS_WDN; }
    } else {
        if (it < IB8)      { r = it - IB7; const int e = r / I_G; r -= e * I_G; W = P.in[16] + (size_t)e * 1024 * 3584; K = 1024; N = 3584; mode = 5; dst = ws + WS_MWGU + (size_t)e * 7168 * 1024; }
        else if (it < IB9) { r = it - IB8; const int e = r / I_G; r -= e * I_G; W = P.in[17] + (size_t)e * 1024 * 3584; K = 1024; N = 3584; mode = 6; dst = ws + WS_MWGU + (size_t)e * 7168 * 1024; }
        else               { r = it - IB9; const int e = r / I_DN; r -= e * I_DN; W = P.in[18] + (size_t)e * 3584 * 1024; K = 3584; N = 1024; mode = 7; dst = ws + WS_MWDN + (size_t)e * 1024 * 3584; }
    }
    const int nblk = N / 256, kb = r / nblk, nb = r - kb * nblk, k0 = kb * 128, n0 = nb * 256;
    {
        f32x4 v[16];
#pragma unroll
        for (int j = 0; j < 16; ++j) v[j] = *(const GAS f32x4*)(W + (size_t)(k0 + wave * 16 + j) * N + n0 + 4 * lane);
#pragma unroll
        for (int j = 0; j < 16; ++j) { v2u w2; w2.x = pk2(v[j][0], v[j][1]); w2.y = pk2(v[j][2], v[j][3]); *(LAS v2u*)(scr + (wave * 16 + j) * SROW + 8 * lane) = w2; }
    }
    __syncthreads();
    const int n = tid & 255, half = tid >> 8;
    const LAS unsigned char* col = scr + 2 * n;
    if (!MOE) {
        bf16* drow = (bf16*)dst + (size_t)map_row(mode, n0 + n) * K + k0 + 64 * half;
#pragma unroll
        for (int c = 0; c < 8; ++c) { unsigned h[8];
#pragma unroll
            for (int i = 0; i < 8; ++i) h[i] = *(const LAS unsigned short*)(col + (64 * half + 8 * c + i) * SROW);
            v4u o; o.x = h[0] | (h[1] << 16); o.y = h[2] | (h[3] << 16); o.z = h[4] | (h[5] << 16); o.w = h[6] | (h[7] << 16);
            pg8::st16(drow + 8 * c, o); }
    } else if (mode == 7) {
        unsigned char* drow = dst + (size_t)(n0 + n) * K + k0 + 64 * half;
#pragma unroll
        for (int c = 0; c < 4; ++c) { float f[16];
#pragma unroll
            for (int i = 0; i < 16; ++i) f[i] = bf_lo((unsigned)*(const LAS unsigned short*)(col + (64 * half + 16 * c + i) * SROW)) * SD8;
            v4u o; o.x = pg8::pk4_fp8(f[0], f[1], f[2], f[3]); o.y = pg8::pk4_fp8(f[4], f[5], f[6], f[7]); o.z = pg8::pk4_fp8(f[8], f[9], f[10], f[11]); o.w = pg8::pk4_fp8(f[12], f[13], f[14], f[15]);
            pg8::st16(drow + 16 * c, o); }
    } else {
        unsigned char* drow = dst + (size_t)map_row8(mode - 5, n0 + n) * K + k0;
#pragma unroll
        for (int blk = 0; blk < 2; ++blk) { const int g = 2 * half + blk; pg8::f32x16 a, b;
#pragma unroll
            for (int i = 0; i < 16; ++i) { a[i] = bf_lo((unsigned)*(const LAS unsigned short*)(col + (32 * g + i) * SROW)); b[i] = bf_lo((unsigned)*(const LAS unsigned short*)(col + (32 * g + 16 + i) * SROW)); }
            pg8::u32x4 c0, c1; pg8::cvt_block6(a, b, c0, c1);
            pg8::st16(drow + 16 * g, c0); pg8::st16(drow + 64 + 16 * g, c1); }
    }
}
struct MoeItem { const float* src; unsigned char* dst; int N, K, mode, k0, n0; };
__device__ __forceinline__ MoeItem moe_item_decode(const Ptrs& P, int it) {
    MoeItem d; int r; unsigned char* ws = P.ws; const float* W;
    if (it < IB7) {
        if (it < IB1)      { r = it - IB0; W = P.in[1];  d.K = 1024; d.N = 1536; d.mode = 1; d.dst = ws + WS_WQKV; }
        else if (it < IB2) { r = it - IB1; W = P.in[3];  d.K = 1024; d.N = 1024; d.mode = 0; d.dst = ws + WS_WO; }
        else if (it < IB3) { r = it - IB2; W = P.in[4];  d.K = 1024; d.N = 2048; d.mode = 4; d.dst = ws + WS_WPW1; }
        else if (it < IB4) { r = it - IB3; W = P.in[10]; d.K = 1024; d.N = 1024; d.mode = 0; d.dst = ws + WS_WPW2; }
        else if (it < IB5) { r = it - IB4; W = P.in[12]; d.K = 1024; d.N = 3584; d.mode = 2; d.dst = ws + WS_WGU; }
        else if (it < IB6) { r = it - IB5; W = P.in[13]; d.K = 1024; d.N = 3584; d.mode = 3; d.dst = ws + WS_WGU; }
        else               { r = it - IB6; W = P.in[14]; d.K = 3584; d.N = 1024; d.mode = 0; d.dst = ws + WS_WDN; }
    }
    else if (it < IB8) { r = it - IB7; const int e = r / I_G; r -= e * I_G; W = P.in[16] + (size_t)e * 1024 * 3584; d.K = 1024; d.N = 3584; d.mode = 5; d.dst = ws + WS_MWGU + (size_t)e * 7168 * 1024; }
    else if (it < IB9) { r = it - IB8; const int e = r / I_G; r -= e * I_G; W = P.in[17] + (size_t)e * 1024 * 3584; d.K = 1024; d.N = 3584; d.mode = 6; d.dst = ws + WS_MWGU + (size_t)e * 7168 * 1024; }
    else               { r = it - IB9; const int e = r / I_DN; r -= e * I_DN; W = P.in[18] + (size_t)e * 3584 * 1024; d.K = 3584; d.N = 1024; d.mode = 7; d.dst = ws + WS_MWDN + (size_t)e * 1024 * 3584; }
    const int nblk = d.N / 256, kb = r / nblk, nb = r - kb * nblk; d.k0 = kb * 128; d.n0 = nb * 256; d.src = W + (size_t)d.k0 * d.N + d.n0;
    return d;
}
__device__ __forceinline__ void moe_weight_items(const Ptrs& P, LAS unsigned char* lds, int bx, int G, int tid, int lane, int wave) {
    constexpr int SROW = 520;
    LAS unsigned char* scr = lds + RING_OFF;
    const int g0 = G / 2, h = bx >= g0 ? 1 : 0, gi = bx - h * g0, gs = h ? G - g0 : g0;
    constexpr int NIT = IT_ALL - IT_P0, HN = NIT / 2;
    const int lo = IT_P0 + h * HN, hi = h ? IT_ALL : IT_P0 + HN;
    int it = lo + gi;
    if (it >= hi) return;
    MoeItem d = moe_item_decode(P, it);
    f32x4 v[16];
#pragma unroll
    for (int j = 0; j < 16; ++j) v[j] = __builtin_nontemporal_load((const GAS f32x4*)(d.src + (size_t)(wave * 16 + j) * d.N + 4 * lane));
    __syncthreads();
    for (;;) {
#pragma unroll
        for (int j = 0; j < 16; ++j) { v2u w2; w2.x = pk2(v[j][0], v[j][1]); w2.y = pk2(v[j][2], v[j][3]); *(LAS v2u*)(scr + (wave * 16 + j) * SROW + 16 * wave + 8 * lane) = w2; }
        __syncthreads();
        const int itn = it + gs; const bool more = itn < hi;
        MoeItem dn = d;
        if (more) { dn = moe_item_decode(P, itn);
#pragma unroll
            for (int j = 0; j < 16; ++j) v[j] = __builtin_nontemporal_load((const GAS f32x4*)(dn.src + (size_t)(wave * 16 + j) * dn.N + 4 * lane)); }
        const int c = lane & 3;
#pragma unroll
        for (int p = 0; p < 2; ++p) {
            const int n = 128 * p + 16 * wave + (lane >> 2);
            const LAS unsigned char* col = scr + 2 * n;
            if (d.mode <= 4) {
                bf16* drow = (bf16*)d.dst + (size_t)map_row(d.mode, d.n0 + n) * d.K + d.k0;
#pragma unroll
                for (int s2 = 0; s2 < 4; ++s2) { unsigned h[8]; const int r0 = 8 * (4 * s2 + c);
#pragma unroll
                    for (int i = 0; i < 8; ++i) h[i] = *(const LAS unsigned short*)(col + (r0 + i) * SROW + 16 * (r0 >> 4));
                    v4u o; o.x = h[0] | (h[1] << 16); o.y = h[2] | (h[3] << 16); o.z = h[4] | (h[5] << 16); o.w = h[6] | (h[7] << 16);
                    pg8::st16(drow + r0, o); }
            } else if (d.mode == 7) {
                unsigned char* drow = d.dst + (size_t)(d.n0 + n) * d.K + d.k0;
#pragma unroll
                for (int s2 = 0; s2 < 2; ++s2) { float f[16]; const int r0 = 64 * s2 + 16 * c;
#pragma unroll
                    for (int i = 0; i < 16; ++i) f[i] = bf_lo((unsigned)*(const LAS unsigned short*)(col + (r0 + i) * SROW + 16 * (4 * s2 + c))) * SD8;
                    v4u o; o.x = pg8::pk4_fp8(f[0], f[1], f[2], f[3]); o.y = pg8::pk4_fp8(f[4], f[5], f[6], f[7]); o.z = pg8::pk4_fp8(f[8], f[9], f[10], f[11]); o.w = pg8::pk4_fp8(f[12], f[13], f[14], f[15]);
                    pg8::st16(drow + r0, o); }
            } else {
                unsigned char* drow = d.dst + (size_t)map_row8(d.mode - 5, d.n0 + n) * d.K + d.k0;
                pg8::f32x16 a, b2;
#pragma unroll
                for (int i = 0; i < 16; ++i) { a[i] = bf_lo((unsigned)*(const LAS unsigned short*)(col + (32 * c + i) * SROW + 32 * c)); b2[i] = bf_lo((unsigned)*(const LAS unsigned short*)(col + (32 * c + 16 + i) * SROW + 32 * c + 16)); }
                pg8::u32x4 c0, c1; pg8::cvt_block6(a, b2, c0, c1);
                pg8::st16(drow + 16 * c, c0); pg8::st16(drow + 64 + 16 * c, c1);
            }
        }
        if (!more) break;
        d = dn; it = itn;
        __syncthreads();
    }
    __syncthreads();
}
__device__ __forceinline__ void p0_prologue(const Ptrs& P, LAS unsigned char* lds, int vcu, int G, int tid, int lane, int wave) {
    unsigned char* ws = P.ws;
    LAS unsigned char* scr = lds + RING_OFF;
    LAS int* cur_item = (LAS int*)(lds + TAB_OFF + 256);
    unsigned* ictr = (unsigned*)(ws + WS_CTL) + CW_ITEM;
    for (int it = blockIdx.x; it < IT_P0; it += G) { __syncthreads(); weight_item<false>(P, scr, it, tid, lane, wave); }
    __syncthreads();
    const int gw = vcu * NWAVES + wave, NGW = G * NWAVES; (void)gw; (void)NGW;
    {
        constexpr int NCH = NTOK * DM / 8 / 512; const GAS f32x4* x4 = (const GAS f32x4*)P.in[0]; GAS v4u* o = (GAS v4u*)(ws + WS_XB);
        const int A = IT_P0 < G ? IT_P0 : G, Q = ((NCH * 7 / 10 + 8 * A) / G + 4) & ~7;
        const int bx = blockIdx.x, start = bx < A ? bx * (Q - 8) : A * (Q - 8) + (bx - A) * Q, cnt = bx < A ? Q - 8 : Q;
        const int nstat = A * (Q - 8) + (G - A) * Q, ndyn = (NCH - nstat) / 8;
        unsigned* xctr = (unsigned*)(ws + WS_CTL) + CW_XCH;
        int ch = start + wave, end = start + cnt; bool dyn = false;
        for (;;) {
            if (ch >= end) {
                __syncthreads();
                if (tid == 0) cur_item[0] = (int)__hip_atomic_fetch_add(xctr, 1u, __ATOMIC_RELAXED, __HIP_MEMORY_SCOPE_AGENT);
                __syncthreads();
                const int c = cur_item[0]; if (c >= ndyn) break;
                ch = nstat + 8 * c + wave; end = ch + 1; dyn = true;
            }
            const GAS f32x4* sp = x4 + (size_t)ch * 1024 + lane; GAS v2u* dp = (GAS v2u*)(o + (size_t)ch * 512) + lane;
            f32x4 a[16];
#pragma unroll
            for (int u = 0; u < 16; ++u) a[u] = __builtin_nontemporal_load(sp + 64 * u);
#pragma unroll
            for (int u = 0; u < 16; ++u) { v2u w; w.x = pk2(a[u][0], a[u][1]); w.y = pk2(a[u][2], a[u][3]); dp[64 * u] = w; }
            ch += dyn ? 1 : NWAVES;
        }
    }
    {
        float* ct = (float*)(ws + WS_COS); float* st = (float*)(ws + WS_SIN);
        for (int i = vcu * NTHR + tid; i < SEQ * 32; i += G * NTHR) { const int pos = i >> 5, j = i & 31;
            const float ang = (float)pos * P.inv_freq[j];
            const double rev = (double)ang * 0.15915494309189535; const float fr = (float)(rev - floor(rev));
            ct[i] = __builtin_amdgcn_cosf(fr); st[i] = __builtin_amdgcn_sinf(fr); }
    }
}

__device__ __forceinline__ int crow(int r, int hi) { return (r & 3) + 8 * (r >> 2) + 4 * hi; }
__device__ __forceinline__ float max3f(float a, float b, float c) { return __builtin_fmaxf(__builtin_fmaxf(a, b), c); }
__device__ __forceinline__ void attn_phase(const Ptrs& P, LAS unsigned char* lds, int G, int tid, int lane, int wave) {
    constexpr int KS_STRIDE = 144, VT_STRIDE = 784, VT_OFF = 384 * KS_STRIDE;
    const bf16* qkv = (const bf16*)(P.ws + WS_QKV); bf16* O = (bf16*)(P.ws + WS_O); const float* sink = P.in[2];
    LAS unsigned char* Ks = lds + RING_OFF; LAS unsigned char* Vt = lds + RING_OFF + VT_OFF;
    const int r32 = lane & 31, hi = lane >> 5, g = wave >> 1, qhalf = wave & 1;
    constexpr int NUNIT = 4 * 64 * 4;
    v4u pk[6], pv[6];
#define ATT_FETCH(uu) do { const int kvh_ = (uu) & 3, blk_ = ((uu) >> 2) & 63, b_ = (uu) >> 8; _Pragma("unroll") for (int j = 0; j < 6; ++j) { \
        const int id = tid + NTHR * j, row = id >> 3, pc = id & 7, kpos = (blk_ - 1) * 128 + row; pk[j] = (v4u){0u, 0u, 0u, 0u}; pv[j] = (v4u){0u, 0u, 0u, 0u}; \
        if (kpos >= 0 && kpos < SEQ) { const bf16* src = qkv + (size_t)(b_ * SEQ + kpos) * NQKV + kvh_ * 64 + pc * 8; pk[j] = *(const GAS v4u*)(src + 1024); pv[j] = *(const GAS v4u*)(src + 1280); } } } while (0)
    if ((int)blockIdx.x < NUNIT) ATT_FETCH((int)blockIdx.x);
    for (int u = blockIdx.x; u < NUNIT; u += G) {
        const int kvh = u & 3, blk = (u >> 2) & 63, b = u >> 8;
#pragma unroll
        for (int j = 0; j < 6; ++j) {
            const int id = tid + NTHR * j, row = id >> 3, pc = id & 7;
            *(LAS v4u*)(Ks + row * KS_STRIDE + pc * 16) = pk[j];
#pragma unroll
            for (int e = 0; e < 8; ++e) *(LAS unsigned short*)(Vt + (pc * 8 + e) * VT_STRIDE + 16 * pc + row * 2) = (unsigned short)((pv[j][e >> 1] >> (16 * (e & 1))) & 0xffffu);
        }
        __syncthreads();
        const int head = kvh * 4 + g; const float sink_l2 = sink[head] * LOG2E;
        bf16x8 qfa[2][4];
        { const size_t tokq = (size_t)b * SEQ + blk * 128 + 64 * qhalf + r32;
#pragma unroll
          for (int s4 = 0; s4 < 4; ++s4) qfa[0][s4] = *(const GAS bf16x8*)(qkv + tokq * NQKV + head * 64 + 16 * s4 + 8 * hi); }
        if (u + G < NUNIT) ATT_FETCH(u + G);
#pragma unroll
        for (int qg = 0; qg < 2; ++qg) {
            const int ql0 = 64 * qhalf + 32 * qg, jt0 = 2 * qhalf + qg;
            const size_t tok = (size_t)b * SEQ + blk * 128 + ql0 + r32;
            if (qg == 1) {
#pragma unroll
                for (int s4 = 0; s4 < 4; ++s4) qfa[1][s4] = *(const GAS bf16x8*)(qkv + tok * NQKV + head * 64 + 16 * s4 + 8 * hi); }
            float m = sink_l2, l = (hi == 0) ? 1.f : 0.f;
            f32x16 o0 = {}, o1 = {};
#pragma unroll
            for (int c = 0; c < 3; ++c) {
                f32x16 S[3];
#pragma unroll
                for (int tt = 0; tt < 3; ++tt) {
                    const int jt = jt0 + 3 * c + tt;
                    const LAS unsigned char* kp = Ks + (32 * jt + r32) * KS_STRIDE + 16 * hi;
                    f32x16 a;
#pragma unroll
                    for (int r = 0; r < 16; ++r) a[r] = -m;
#pragma unroll
                    for (int s = 0; s < 4; ++s) { const bf16x8 kf = *(const LAS bf16x8*)(kp + 32 * s); a = __builtin_amdgcn_mfma_f32_32x32x16_bf16(kf, qfa[qg][s], a, 0, 0, 0); }
                    const int tau = 3 * c + tt, kpos0 = (blk - 1) * 128 + 32 * jt;
                    if (tau == 0) {
#pragma unroll
                        for (int r = 0; r < 16; ++r) a[r] = (crow(r, hi) >= r32) ? a[r] : -INFINITY; }
                    if (tau == 8) {
#pragma unroll
                        for (int r = 0; r < 16; ++r) a[r] = (crow(r, hi) <= r32) ? a[r] : -INFINITY; }
                    if (kpos0 < 0 || kpos0 >= SEQ) {
#pragma unroll
                        for (int r = 0; r < 16; ++r) a[r] = -INFINITY; }
                    S[tt] = a;
                }
                float cm = -INFINITY;
#pragma unroll
                for (int tt = 0; tt < 3; ++tt) {
#pragma unroll
                    for (int r = 0; r < 16; r += 2) cm = max3f(cm, S[tt][r], S[tt][r + 1]); }
                cm = __builtin_fmaxf(cm, __shfl_xor(cm, 32));
                if (__any(cm > 8.f)) { const float d = __builtin_fmaxf(cm, 0.f), f = __builtin_amdgcn_exp2f(-d); l *= f; o0 *= f; o1 *= f; m += d;
#pragma unroll
                    for (int tt = 0; tt < 3; ++tt)
#pragma unroll
                        for (int r = 0; r < 16; ++r) S[tt][r] -= d; }
                float ls = 0.f;
#pragma unroll
                for (int tt = 0; tt < 3; ++tt)
#pragma unroll
                    for (int r = 0; r < 16; ++r) { const float p = __builtin_amdgcn_exp2f(S[tt][r]); S[tt][r] = p; ls += p; }
                l += ls;
#pragma unroll
                for (int tt = 0; tt < 3; ++tt) {
                    const int jt = jt0 + 3 * c + tt;
#pragma unroll
                    for (int ks = 0; ks < 2; ++ks) {
                        v4u pw; pw.x = pk2(S[tt][8 * ks + 0], S[tt][8 * ks + 1]); pw.y = pk2(S[tt][8 * ks + 2], S[tt][8 * ks + 3]); pw.z = pk2(S[tt][8 * ks + 4], S[tt][8 * ks + 5]); pw.w = pk2(S[tt][8 * ks + 6], S[tt][8 * ks + 7]);
                        const bf16x8 pf = __builtin_bit_cast(bf16x8, pw);
                        const LAS unsigned char* vp = Vt + r32 * VT_STRIDE + 16 * (r32 >> 3) + (32 * jt + 16 * ks + 4 * hi) * 2;
                        { const v2u lo = *(const LAS v2u*)(vp), hi2 = *(const LAS v2u*)(vp + 16); const v4u vw = (v4u){lo.x, lo.y, hi2.x, hi2.y};
                          o0 = __builtin_amdgcn_mfma_f32_32x32x16_bf16(__builtin_bit_cast(bf16x8, vw), pf, o0, 0, 0, 0); }
                        { const v2u lo = *(const LAS v2u*)(vp + 32 * VT_STRIDE + 64), hi2 = *(const LAS v2u*)(vp + 32 * VT_STRIDE + 64 + 16); const v4u vw = (v4u){lo.x, lo.y, hi2.x, hi2.y};
                          o1 = __builtin_amdgcn_mfma_f32_32x32x16_bf16(__builtin_bit_cast(bf16x8, vw), pf, o1, 0, 0, 0); }
                    }
                }
            }
            l += __shfl_xor(l, 32);
            const float inv = 1.f / l;
            bf16* op = O + tok * DM + head * 64 + 4 * hi;
#pragma unroll
            for (int r4 = 0; r4 < 4; ++r4) {
                v2u w; w.x = pk2(o0[4 * r4] * inv, o0[4 * r4 + 1] * inv); w.y = pk2(o0[4 * r4 + 2] * inv, o0[4 * r4 + 3] * inv); pg8::st8(op + 8 * r4, w);
                v2u w1; w1.x = pk2(o1[4 * r4] * inv, o1[4 * r4 + 1] * inv); w1.y = pk2(o1[4 * r4 + 2] * inv, o1[4 * r4 + 3] * inv); pg8::st8(op + 32 + 8 * r4, w1);
            }
        }
        __syncthreads();
    }
#undef ATT_FETCH
}

struct Row16 { float v[16]; };
__device__ __forceinline__ void ln_row(Row16& x, const Row16& gm, const Row16& bt) {
    float s = 0.f;
#pragma unroll
    for (int i = 0; i < 16; ++i) s += x.v[i];
    const float mean = wave_sum(s) * (1.f / DM); float q = 0.f;
#pragma unroll
    for (int i = 0; i < 16; ++i) { x.v[i] -= mean; q += x.v[i] * x.v[i]; }
    const float rstd = __builtin_amdgcn_rsqf(wave_sum(q) * (1.f / DM) + LN_EPS);
#pragma unroll
    for (int i = 0; i < 16; ++i) x.v[i] = x.v[i] * rstd * gm.v[i] + bt.v[i];
}
__device__ __forceinline__ void load_vec16(Row16& r, const float* p, int lane) {
#pragma unroll
    for (int j = 0; j < 2; ++j) { const f32x4 a = *(const GAS f32x4*)(p + 8 * lane + 512 * j), b = *(const GAS f32x4*)(p + 8 * lane + 512 * j + 4);
#pragma unroll
        for (int i = 0; i < 4; ++i) { r.v[8 * j + i] = a[i]; r.v[8 * j + 4 + i] = b[i]; } }
}
__device__ __forceinline__ void load_bf16row(Row16& r, const bf16* p, int lane) {
#pragma unroll
    for (int j = 0; j < 2; ++j) { const v4u w = *(const GAS v4u*)(p + 8 * lane + 512 * j);
        r.v[8 * j + 0] = bf_lo(w.x); r.v[8 * j + 1] = bf_hi(w.x); r.v[8 * j + 2] = bf_lo(w.y); r.v[8 * j + 3] = bf_hi(w.y);
        r.v[8 * j + 4] = bf_lo(w.z); r.v[8 * j + 5] = bf_hi(w.z); r.v[8 * j + 6] = bf_lo(w.w); r.v[8 * j + 7] = bf_hi(w.w); }
}
__device__ __forceinline__ void load_bf16row_nt(Row16& r, const bf16* p, int lane) {
#pragma unroll
    for (int j = 0; j < 2; ++j) { const v4u w = __builtin_nontemporal_load((const GAS v4u*)(p + 8 * lane + 512 * j));
        r.v[8 * j + 0] = bf_lo(w.x); r.v[8 * j + 1] = bf_hi(w.x); r.v[8 * j + 2] = bf_lo(w.y); r.v[8 * j + 3] = bf_hi(w.y);
        r.v[8 * j + 4] = bf_lo(w.z); r.v[8 * j + 5] = bf_hi(w.z); r.v[8 * j + 6] = bf_lo(w.w); r.v[8 * j + 7] = bf_hi(w.w); }
}
__device__ __forceinline__ void store_bf16row(const Row16& r, bf16* p, int lane) {
#pragma unroll
    for (int j = 0; j < 2; ++j) { v4u w; w.x = pk2(r.v[8 * j], r.v[8 * j + 1]); w.y = pk2(r.v[8 * j + 2], r.v[8 * j + 3]); w.z = pk2(r.v[8 * j + 4], r.v[8 * j + 5]); w.w = pk2(r.v[8 * j + 6], r.v[8 * j + 7]);
        pg8::st16(p + 8 * lane + 512 * j, w); }
}
__device__ __forceinline__ void ln_phase(const bf16* src, const float* g, const float* bta, bf16* dst, int vcu, int G, int lane, int wave) {
    Row16 gm, bt; load_vec16(gm, g, lane); load_vec16(bt, bta, lane);
    const int stride = G * NWAVES;
    v4u pw[4][2];
#pragma unroll
    for (int j = 0; j < 4; ++j) { const int row = vcu * NWAVES + wave + j * stride; if (row < NTOK) {
#pragma unroll
        for (int q = 0; q < 2; ++q) pw[j][q] = __builtin_nontemporal_load((const GAS v4u*)(src + (size_t)row * DM + 8 * lane + 512 * q)); } }
    for (int row0 = vcu * NWAVES + wave; row0 < NTOK; row0 += 4 * stride) {
        Row16 x[4];
#pragma unroll
        for (int j = 0; j < 4; ++j)
#pragma unroll
            for (int q = 0; q < 2; ++q) { const v4u w = pw[j][q];
                x[j].v[8 * q + 0] = bf_lo(w.x); x[j].v[8 * q + 1] = bf_hi(w.x); x[j].v[8 * q + 2] = bf_lo(w.y); x[j].v[8 * q + 3] = bf_hi(w.y);
                x[j].v[8 * q + 4] = bf_lo(w.z); x[j].v[8 * q + 5] = bf_hi(w.z); x[j].v[8 * q + 6] = bf_lo(w.w); x[j].v[8 * q + 7] = bf_hi(w.w); }
#pragma unroll
        for (int j = 0; j < 4; ++j) { const int row = row0 + 4 * stride + j * stride; if (row < NTOK) {
#pragma unroll
            for (int q = 0; q < 2; ++q) pw[j][q] = __builtin_nontemporal_load((const GAS v4u*)(src + (size_t)row * DM + 8 * lane + 512 * q)); } }
#pragma unroll
        for (int j = 0; j < 4; ++j) { const int row = row0 + j * stride; if (row < NTOK) { ln_row(x[j], gm, bt); store_bf16row(x[j], dst + (size_t)row * DM, lane); } }
    }
}
__device__ __forceinline__ void ln_router_phase(const Ptrs& P, LAS unsigned char* lds, const bf16* src, const float* g, const float* bta, bf16* dst, int G, int tid, int lane, int wave) {
    const float* router = P.in[15]; int* topi = (int*)(P.ws + WS_TOPI); float* gate = (float*)(P.ws + WS_GATE); int* wgcnt = (int*)(P.ws + WS_WGCNT);
    LAS int* hist = (LAS int*)(lds + RING_OFF);
    if (tid < 8) hist[tid] = 0;
    __syncthreads();
    const int tpw = (NTOK + G - 1) / G, t0 = blockIdx.x * tpw, t1 = (t0 + tpw < NTOK) ? t0 + tpw : NTOK;
    {
        Row16 gm, bt; load_vec16(gm, g, lane); load_vec16(bt, bta, lane);
        LAS f32x4* rw = (LAS f32x4*)(lds + RING_OFF + 1024);
        if (wave == 0) {
#pragma unroll
            for (int j = 0; j < 2; ++j)
#pragma unroll
                for (int i = 0; i < 8; ++i) { const float* rp = router + (size_t)(8 * lane + 512 * j + i) * 8; rw[((8 * j + i) * 2 + 0) * 64 + lane] = *(const GAS f32x4*)rp; rw[((8 * j + i) * 2 + 1) * 64 + lane] = *(const GAS f32x4*)(rp + 4); }
        }
        __syncthreads();
        int cnt[8];
#pragma unroll
        for (int e = 0; e < 8; ++e) cnt[e] = 0;
        const int rstep = 2 * NWAVES;
        Row16 xn[2];
#pragma unroll
        for (int r = 0; r < 2; ++r) { const int row = t0 + wave + r * NWAVES; if (row < t1) load_bf16row_nt(xn[r], src + (size_t)row * DM, lane); }
        for (int row0 = t0 + wave; row0 < t1; row0 += rstep) {
            Row16 x[2]; bool ok[2];
#pragma unroll
            for (int r = 0; r < 2; ++r) { x[r] = xn[r]; ok[r] = row0 + r * NWAVES < t1; }
#pragma unroll
            for (int r = 0; r < 2; ++r) { const int row = row0 + rstep + r * NWAVES; if (row < t1) load_bf16row_nt(xn[r], src + (size_t)row * DM, lane); }
            if (!ok[1]) x[1] = x[0];
#pragma unroll
            for (int r = 0; r < 2; ++r) ln_row(x[r], gm, bt);
#pragma unroll
            for (int r = 0; r < 2; ++r) if (ok[r]) store_bf16row(x[r], dst + (size_t)(row0 + r * NWAVES) * X3_STRIDE, lane);
            f32x4 la[2], lb[2];
#pragma unroll
            for (int r = 0; r < 2; ++r) { la[r] = (f32x4){0.f, 0.f, 0.f, 0.f}; lb[r] = la[r]; }
#pragma unroll
            for (int i = 0; i < 16; ++i) { const f32x4 wa = rw[(i * 2 + 0) * 64 + lane], wb = rw[(i * 2 + 1) * 64 + lane];
#pragma unroll
                for (int r = 0; r < 2; ++r) { const float xv = x[r].v[i]; la[r] += wa * xv; lb[r] += wb * xv; } }
#pragma unroll
            for (int r = 0; r < 2; ++r) {
                float lg[8];
#pragma unroll
                for (int e = 0; e < 4; ++e) { lg[e] = la[r][e]; lg[4 + e] = lb[r][e]; }
                { float red8[8]; wave_sum8(lg, red8);
#pragma unroll
                  for (int e = 0; e < 8; ++e) lg[e] = red8[e]; }
                int i1 = 0; float v1 = lg[0];
#pragma unroll
                for (int e = 1; e < 8; ++e) if (lg[e] > v1) { v1 = lg[e]; i1 = e; }
                int i2 = -1; float v2 = -INFINITY;
#pragma unroll
                for (int e = 0; e < 8; ++e) if (e != i1 && lg[e] > v2) { v2 = lg[e]; i2 = e; }
                const float e2 = __builtin_amdgcn_exp2f((v2 - v1) * LOG2E), g1 = __builtin_amdgcn_rcpf(1.f + e2), g2 = e2 * g1;
                const int row = row0 + r * NWAVES;
                if (ok[r] && lane == 0) { topi[2 * row] = i1; topi[2 * row + 1] = i2; gate[2 * row] = g1; gate[2 * row + 1] = g2; }
#pragma unroll
                for (int e = 0; e < 8; ++e) cnt[e] += (ok[r] && (i1 == e || i2 == e)) ? 1 : 0;
            }
        }
        if (lane == 0) {
#pragma unroll
            for (int e = 0; e < 8; ++e) atomicAdd((int*)(hist + e), cnt[e]);
        }
    }
    __syncthreads();
    if (tid < 8) wgcnt[blockIdx.x * 8 + tid] = hist[tid];
    __syncthreads();
}
__device__ __forceinline__ void route_phase(const Ptrs& P, LAS unsigned char* lds, int G, int tid, int lane, int wave) {
    const int* topi = (const int*)(P.ws + WS_TOPI); const int* wgcnt = (const int*)(P.ws + WS_WGCNT); int* posof = (int*)(P.ws + WS_POS);
    const bf16* x3 = (const bf16*)P.out; unsigned char* xs = P.ws + WS_XS;
    LAS int* tot = (LAS int*)(lds + RING_OFF); LAS int* bef = tot + 8; LAS int* base = tot + 16; LAS int* posl = tot + 64;
    LAS int* ts = (LAS int*)(lds + TAB_OFF);
    if (tid < 16) tot[tid] = 0;
    __syncthreads();
    { const int e = tid & 7; int a = 0, bsum = 0;
      for (int w = tid >> 3; w < G; w += NTHR / 8) { const int c = wgcnt[w * 8 + e]; a += c; if (w < (int)blockIdx.x) bsum += c; }
      atomicAdd((int*)(tot + e), a); atomicAdd((int*)(bef + e), bsum); }
    __syncthreads();
    if (tid == 0) { int t = 0;
        for (int e = 0; e < 8; ++e) { ts[e] = t; base[e] = t * 256 + bef[e]; t += (tot[e] + 255) >> 8; }
        ts[8] = t; }
    __syncthreads();
    const int tpw = (NTOK + G - 1) / G, t0 = blockIdx.x * tpw, t1 = (t0 + tpw < NTOK) ? t0 + tpw : NTOK, nq = 2 * (t1 - t0);
    if (wave == 0) {
        int bs[8];
#pragma unroll
        for (int e = 0; e < 8; ++e) bs[e] = base[e];
        for (int q0 = 0; q0 < nq; q0 += 64) {
            const int q = q0 + lane; const int myE = (q < nq) ? topi[2 * t0 + q] : -1; int pos = 0;
#pragma unroll
            for (int e = 0; e < 8; ++e) { const unsigned long long bal = __ballot(myE == e); const int below = __builtin_popcountll(bal & ((1ull << lane) - 1ull));
                if (myE == e) pos = bs[e] + below; bs[e] += __builtin_popcountll(bal); }
            if (q < nq) { posl[q] = pos; posof[2 * t0 + q] = pos; }
        }
    }
    __syncthreads();
    for (int t2 = 2 * wave; t2 < (t1 - t0); t2 += 2 * NWAVES) {
        const int tl = t2 + (lane >> 5), b = lane & 31;
        if (tl < t1 - t0) { const bf16* sp = x3 + (size_t)(t0 + tl) * X3_STRIDE + 32 * b;
            v4u w[4];
#pragma unroll
            for (int i = 0; i < 4; ++i) w[i] = *(const GAS v4u*)(sp + 8 * i);
            pg8::f32x16 fa, fb;
#pragma unroll
            for (int i = 0; i < 2; ++i) { fa[8 * i + 0] = bf_lo(w[i].x); fa[8 * i + 1] = bf_hi(w[i].x); fa[8 * i + 2] = bf_lo(w[i].y); fa[8 * i + 3] = bf_hi(w[i].y); fa[8 * i + 4] = bf_lo(w[i].z); fa[8 * i + 5] = bf_hi(w[i].z); fa[8 * i + 6] = bf_lo(w[i].w); fa[8 * i + 7] = bf_hi(w[i].w);
                fb[8 * i + 0] = bf_lo(w[2 + i].x); fb[8 * i + 1] = bf_hi(w[2 + i].x); fb[8 * i + 2] = bf_lo(w[2 + i].y); fb[8 * i + 3] = bf_hi(w[2 + i].y); fb[8 * i + 4] = bf_lo(w[2 + i].z); fb[8 * i + 5] = bf_hi(w[2 + i].z); fb[8 * i + 6] = bf_lo(w[2 + i].w); fb[8 * i + 7] = bf_hi(w[2 + i].w); }
            pg8::u32x4 c0, c1; pg8::cvt_block6(fa, fb, c0, c1);
            const int boff = 128 * (b >> 2) + 16 * (b & 3);
            unsigned char* d0 = xs + (size_t)posl[2 * tl] * DM + boff; unsigned char* d1 = xs + (size_t)posl[2 * tl + 1] * DM + boff;
            pg8::st16(d0, c0); pg8::st16(d0 + 64, c1); pg8::st16(d1, c0); pg8::st16(d1 + 64, c1); }
    }
    { const int e = wave; const int r0 = ts[e] * 256 + tot[e], r1 = ts[e + 1] * 256;
        for (int r = r0 + (int)blockIdx.x; r < r1; r += G) *(GAS v4u*)(xs + (size_t)r * DM + 16 * lane) = (v4u){0u, 0u, 0u, 0u}; }
    __syncthreads();
}
__device__ __forceinline__ void load_yrow(Row16& r, const bf16* ys, const float* tailp, int pos, int lane) {
    if (pos < 65536) { load_bf16row_nt(r, ys + (size_t)pos * DM, lane); return; }
#pragma unroll
    for (int i = 0; i < 16; ++i) r.v[i] = 0.f;
    for (int ks = 0; ks < 7; ++ks) { Row16 t; load_vec16(t, tailp + ((size_t)ks * 2048 + (pos - 65536)) * DM, lane);
#pragma unroll
        for (int i = 0; i < 16; ++i) r.v[i] += t.v[i]; }
}
__device__ __forceinline__ void combine_phase(const Ptrs& P, const float* g, const float* bta, int vcu, int G, int lane, int wave) {
    const bf16* x3 = (const bf16*)P.out; const bf16* ys = (const bf16*)(P.ws + WS_YS); const int* posof = (const int*)(P.ws + WS_POS); const float* gate = (const float*)(P.ws + WS_GATE);
    const float* tailp = (const float*)(P.ws + WS_TAILP);
    Row16 gm, bt; load_vec16(gm, g, lane); load_vec16(bt, bta, lane);
    const int stride = G * NWAVES;
    for (int row0 = vcu * NWAVES + wave; row0 < NTOK; row0 += 2 * stride) {
        Row16 x[2], y1[2], y2[2]; float g1[2], g2[2];
#pragma unroll
        for (int j = 0; j < 2; ++j) { const int row = row0 + j * stride; if (row < NTOK) {
            const int p1 = posof[2 * row], p2 = posof[2 * row + 1]; g1[j] = gate[2 * row]; g2[j] = gate[2 * row + 1];
            load_bf16row_nt(x[j], x3 + (size_t)row * X3_STRIDE, lane); load_yrow(y1[j], ys, tailp, p1, lane); load_yrow(y2[j], ys, tailp, p2, lane); } }
#pragma unroll
        for (int j = 0; j < 2; ++j) { const int row = row0 + j * stride; if (row < NTOK) {
#pragma unroll
            for (int i = 0; i < 16; ++i) x[j].v[i] = DN_ALPHA * x[j].v[i] + (g1[j] * y1[j].v[i] + g2[j] * y2[j].v[i]);
            ln_row(x[j], gm, bt);
            float* o = P.out + (size_t)row * DM;
#pragma unroll
            for (int jj = 0; jj < 2; ++jj) { *(GAS f32x4*)(o + 8 * lane + 512 * jj) = (f32x4){x[j].v[8 * jj], x[j].v[8 * jj + 1], x[j].v[8 * jj + 2], x[j].v[8 * jj + 3]}; *(GAS f32x4*)(o + 8 * lane + 512 * jj + 4) = (f32x4){x[j].v[8 * jj + 4], x[j].v[8 * jj + 5], x[j].v[8 * jj + 6], x[j].v[8 * jj + 7]}; }
        } }
    }
}

__device__ __forceinline__ void conv_phase(const Ptrs& P, LAS unsigned char* lds, int G, int tid, int lane, int wave) {
    const bf16* gin = (const bf16*)(P.ws + WS_G1); bf16* cout = (bf16*)(P.ws + WS_C1);
    const float* dw = P.in[6]; const float* dwb = P.in[7]; const float* ng = P.in[8]; const float* nb = P.in[9];
    LAS float* wl = (LAS float*)(lds + RING_OFF);
    LAS float* red0 = (LAS float*)(lds + RING_OFF + 31 * 1024 * 4);
    for (int i = tid; i < 31 * 256; i += NTHR) ((LAS f32x4*)wl)[i] = ((const GAS f32x4*)dw)[i];
    __syncthreads();
    const int tg = wave >> 2, c0 = 4 * ((wave & 3) * 64 + lane);
    const f32x4 bias = *(const GAS f32x4*)(dwb + c0), gg = *(const GAS f32x4*)(ng + c0), gb = *(const GAS f32x4*)(nb + c0);
#define CONV_LOAD(dst, ib, TOK0, S0) do { _Pragma("unroll") for (int j = 0; j < 8; ++j) { const int i = (ib) + j, sq = (S0) + i; dst[j] = (v2u){0u, 0u}; if (i < 38 && sq >= 0 && sq < SEQ) dst[j] = *(const GAS v2u*)(gin + (size_t)((TOK0) - 15 + i) * DM + c0); } } while (0)
#define CONV_LOAD_ALL(TOK0, S0) do { CONV_LOAD(x0, 0, TOK0, S0); CONV_LOAD(x1, 8, TOK0, S0); CONV_LOAD(x2, 16, TOK0, S0); CONV_LOAD(x3, 24, TOK0, S0); CONV_LOAD(x4, 32, TOK0, S0); } while (0)
#define CONV_BLOCK(ib, STATIC, xc) do { \
            _Pragma("unroll") for (int j = 0; j < 8; ++j) { const int i = (ib) + j; \
                if (STATIC) { if (i <= 30) W[j] = *(const LAS f32x4*)(wl + i * 1024 + c0); } else W[j] = (i <= 30) ? *(const LAS f32x4*)(wl + i * 1024 + c0) : (f32x4){0.f, 0.f, 0.f, 0.f}; \
                if (!(STATIC) || i < 38) { const f32x4 x = (f32x4){bf_lo(xc[j].x), bf_hi(xc[j].x), bf_lo(xc[j].y), bf_hi(xc[j].y)}; \
                    _Pragma("unroll") for (int o = 0; o < 8; ++o) { const int k = i - o; if (!(STATIC) || (k >= 0 && k <= 30)) acc[o] += x * W[(j - o) & 7]; } } } } while (0)
    v2u x0[8], x1[8], x2[8], x3[8], x4[8];
    if ((int)blockIdx.x < NTOK / 16) { const int tk = (int)blockIdx.x * 16 + 8 * tg; CONV_LOAD_ALL(tk, (tk & (SEQ - 1)) - 15); }
    int par = 0;
    for (int tile = blockIdx.x; tile < NTOK / 16; tile += G) {
        const int tok0 = tile * 16 + 8 * tg;
        LAS float* red = red0 + par * 128; par ^= 1;
        f32x4 acc[8], W[8];
#pragma unroll
        for (int o = 0; o < 8; ++o) { acc[o] = bias; W[o] = (f32x4){0.f, 0.f, 0.f, 0.f}; }
        CONV_BLOCK(0, true, x0);
#pragma unroll 1
        for (int ib = 8; ib < 32; ib += 8) { v2u xc[8];
#pragma unroll
            for (int j = 0; j < 8; ++j) { xc[j] = x1[j]; x1[j] = x2[j]; x2[j] = x3[j]; }
            CONV_BLOCK(ib, false, xc); }
        CONV_BLOCK(32, true, x4);
        if (tile + G < NTOK / 16) { const int tk = (tile + G) * 16 + 8 * tg; CONV_LOAD_ALL(tk, (tk & (SEQ - 1)) - 15); }
#undef CONV_LOAD_ALL
#undef CONV_BLOCK
#undef CONV_LOAD
        { float s1v[8], s2v[8], r1[8], r2[8];
#pragma unroll
          for (int o = 0; o < 8; ++o) { const f32x4 a = acc[o]; s1v[o] = (a[0] + a[1]) + (a[2] + a[3]); s2v[o] = (a[0] * a[0] + a[1] * a[1]) + (a[2] * a[2] + a[3] * a[3]); }
          wave_sum8(s1v, r1); wave_sum8(s2v, r2);
          if (lane == 0) {
#pragma unroll
              for (int o = 0; o < 8; ++o) *(LAS f32x2v*)(red + ((tg * 8 + o) * 4 + (wave & 3)) * 2) = (f32x2v){r1[o], r2[o]}; } }
        __syncthreads();
#pragma unroll
        for (int o = 0; o < 8; ++o) {
            const f32x4 ra = *(const LAS f32x4*)(red + (tg * 8 + o) * 8), rb = *(const LAS f32x4*)(red + (tg * 8 + o) * 8 + 4);
            const float s1 = (ra[0] + ra[2]) + (rb[0] + rb[2]), s2 = (ra[1] + ra[3]) + (rb[1] + rb[3]);
            const float mean = s1 * (1.f / DM); float var = s2 * (1.f / DM) - mean * mean; var = var < 0.f ? 0.f : var; const float rstd = __builtin_amdgcn_rsqf(var + LN_EPS);
            f32x4 t = (acc[o] - mean) * rstd * gg + gb;
            t = t * pg8::sigmoid4(t, -1.4426950408889634f);
            v2u w; w.x = pk2(t[0], t[1]); w.y = pk2(t[2], t[3]);
            pg8::st8(cout + (size_t)(tok0 + o) * DM + c0, w); }
    }
    __syncthreads();
}

constexpr int NPH = 15;
struct Args { const float* in[23]; float* out; unsigned char* ws; int ph_lo, ph_hi, li, pad; float inv_freq[32]; };
__global__ void __launch_bounds__(NTHR, 2) fwd_kernel(Args args) {
    extern __shared__ __attribute__((aligned(16))) unsigned char lds_raw[];
    LAS unsigned char* lds = (LAS unsigned char*)lds_raw;
    const int tid = threadIdx.x, lane = tid & 63, wave = __builtin_amdgcn_readfirstlane(tid >> 6);
    const int G = gridDim.x; const int bx = blockIdx.x; const int vcu = (G % 8 == 0) ? (bx % 8) * (G / 8) + bx / 8 : bx;
    Ptrs P;
#pragma unroll
    for (int i = 0; i < 23; ++i) P.in[i] = args.in[i];
    P.out = args.out; P.ws = args.ws; P.inv_freq = args.inv_freq;
    unsigned char* ws = args.ws;
    gu32* ctl = (gu32*)(ws + WS_CTL);
    for (int u = tid; u < (LDS_BYTES - LDSCTL_OFF) / 4; u += NTHR) ((LAS unsigned*)(lds + LDSCTL_OFF))[u] = 0u;
    __syncthreads();
    volatile LAS unsigned* MISC = (volatile LAS unsigned*)(lds + MISC_OFF);
    XcdBarrier bar = xcd_barrier_post((unsigned*)(ctl + CW_BAR) + args.li * XCD_BAR_WORDS, MISC + 8);
    const int lo = args.ph_lo, hi = args.ph_hi;
#define IN(k) (lo <= (k) && (k) < hi)
#define SEAM(k) do { if (IN(k) && IN((k) + 1)) xcd_barrier(bar); } while (0)
    const float* ln_mix_g = P.in[19]; const float* ln_mix_b = P.in[20]; const float* ln_ffn_g = P.in[21]; const float* ln_ffn_b = P.in[22];
    pg8::bf16_t* vbuf = (pg8::bf16_t*)P.out;

    if (IN(0)) { p0_prologue(P, lds, vcu, G, tid, lane, wave); } SEAM(0);
    if (IN(1)) {
        pg8::Gemm g{(const pg8::bf16_t*)(ws + WS_XB), (const pg8::bf16_t*)(ws + WS_WQKV), 1024, 0, 0, 0};
        pg8::StaticOrder S; S.init(NTOK / 256, NQKV / 256, G, bx);
        pg8::EpiQKV E{(pg8::bf16_t*)(ws + WS_QKV), (const float*)(ws + WS_COS), (const float*)(ws + WS_SIN), 0.125f * LOG2E};
        pg8::gemm_phase<0>(lds + RING_OFF, g, S, E);
    } SEAM(1);
    if (IN(2)) { if (2 * bx < G) moe_weight_items(P, lds, bx, G, tid, lane, wave); attn_phase(P, lds, G, tid, lane, wave); if (2 * bx >= G) moe_weight_items(P, lds, bx, G, tid, lane, wave); } SEAM(2);
    if (IN(3)) {
        pg8::Gemm g{(const pg8::bf16_t*)(ws + WS_O), (const pg8::bf16_t*)(ws + WS_WO), 1024, 0, 0, 0};
        pg8::StaticOrder S; S.init(NTOK / 256, DM / 256, G, bx);
        pg8::EpiResBf16<false> E{vbuf, (const void*)P.in[0], nullptr, DN_ALPHA};
        pg8::gemm_phase<0>(lds + RING_OFF, g, S, E);
    } SEAM(3);
    if (IN(4)) { ln_phase(vbuf, ln_mix_g, ln_mix_b, (bf16*)(ws + WS_X1B), vcu, G, lane, wave); } SEAM(4);
    if (IN(5)) {
        pg8::Gemm g{(const pg8::bf16_t*)(ws + WS_X1B), (const pg8::bf16_t*)(ws + WS_WGU), 1024, 0, 0, 0};
        pg8::StaticOrder S; S.init(NTOK / 256, 2 * FF / 256, G, bx);
        pg8::EpiGated<0> E{(pg8::bf16_t*)(ws + WS_H), FF, nullptr, 0, HBLK};
#if PROBE_SPLIT
        S.i1 = 7; pg8::gemm_phase<0>(lds + RING_OFF, g, S, E); xcd_barrier(bar); S.i0 = 7; S.i1 = 1 << 30;
#endif
        pg8::gemm_phase<0>(lds + RING_OFF, g, S, E);
    } SEAM(5);
    if (IN(6)) {
        pg8::Gemm g{(const pg8::bf16_t*)(ws + WS_H), (const pg8::bf16_t*)(ws + WS_WDN), FF, 0, HBLK, 0};
        pg8::StaticOrder S; S.init(NTOK / 256, DM / 256, G, bx);
        pg8::EpiResBf16<true> E{vbuf, (const void*)(ws + WS_X1B), nullptr, DN_ALPHA};
        pg8::gemm_phase<0>(lds + RING_OFF, g, S, E);
    } SEAM(6);
    if (IN(7)) { ln_phase(vbuf, ln_ffn_g, ln_ffn_b, (bf16*)(ws + WS_X2B), vcu, G, lane, wave); } SEAM(7);
    if (IN(8)) {
        pg8::Gemm g{(const pg8::bf16_t*)(ws + WS_X2B), (const pg8::bf16_t*)(ws + WS_WPW1), 1024, 0, 0, 0};
        pg8::StaticOrder S; S.init(NTOK / 256, 2048 / 256, G, bx);
        pg8::EpiGated<1> E{(pg8::bf16_t*)(ws + WS_G1), DM, P.in[5], 1024, 0};
        pg8::gemm_phase<0>(lds + RING_OFF, g, S, E);
    } SEAM(8);
    if (IN(9)) { conv_phase(P, lds, G, tid, lane, wave); } SEAM(9);
    if (IN(10)) {
        pg8::Gemm g{(const pg8::bf16_t*)(ws + WS_C1), (const pg8::bf16_t*)(ws + WS_WPW2), 1024, 0, 0, 0};
        pg8::StaticOrder S; S.init(NTOK / 256, DM / 256, G, bx);
        pg8::EpiResBf16<true> E{(pg8::bf16_t*)(ws + WS_VPW2), (const void*)(ws + WS_X2B), P.in[11], DN_ALPHA};
        pg8::gemm_phase<0>(lds + RING_OFF, g, S, E);
    } SEAM(10);
    if (IN(11)) { ln_router_phase(P, lds, (const bf16*)(ws + WS_VPW2), ln_mix_g + DM, ln_mix_b + DM, (bf16*)P.out, G, tid, lane, wave); } SEAM(11);
    if (IN(12)) { route_phase(P, lds, G, tid, lane, wave); } SEAM(12);
    if (IN(13)) {
        LAS int* tsl = (LAS int*)(lds + TAB_OFF);
        if (!IN(12)) {
            __syncthreads();
            LAS int* tot = (LAS int*)(lds + RING_OFF);
            if (tid < 8) tot[tid] = 0;
            __syncthreads();
            { const int e = tid & 7; int a = 0; const int* wgcnt = (const int*)(ws + WS_WGCNT);
              for (int w = tid >> 3; w < G; w += NTHR / 8) a += wgcnt[w * 8 + e];
              atomicAdd((int*)(tot + e), a); }
            __syncthreads();
            if (tid == 0) { int t = 0; for (int e = 0; e < 8; ++e) { tsl[e] = t; t += (tot[e] + 255) >> 8; } tsl[8] = t; }
            __syncthreads();
        }
        int ts[9];
#pragma unroll
        for (int e = 0; e < 9; ++e) ts[e] = __builtin_amdgcn_readfirstlane(tsl[e]);
        const int ntile = ts[8];
        for (int t0 = 0; t0 < ntile; t0 += MOE_CHUNK_TILES) {
            const int nT = (ntile - t0) < MOE_CHUNK_TILES ? (ntile - t0) : MOE_CHUNK_TILES;
            {
                pg8::Gemm g{(const pg8::bf16_t*)(ws + WS_XS + (size_t)t0 * 256 * DM), (const pg8::bf16_t*)(ws + WS_MWGU), 512, (size_t)7168 * 1024, 0, 0};
                pg8::MoeOrder S; S.so.init(nT, 2 * FF / 256, G, bx); S.t0 = t0;
#pragma unroll
                for (int e = 0; e < 9; ++e) S.ts[e] = ts[e];
                pg8::EpiGated8 E{ws + WS_HC, FF, 1.f, SH8};
                pg8::gemm_phase<2>(lds + RING_OFF, g, S, E);
            }
            xcd_barrier(bar);
            {
                pg8::Gemm g{(const pg8::bf16_t*)(ws + WS_HC), (const pg8::bf16_t*)(ws + WS_MWDN), FF / 2, (size_t)1024 * FF, 1, 0};
                const int nmain = nT < 256 ? nT : 256;
                pg8::MoeOrder S; S.so.init(nmain, DM / 256, G, bx); S.t0 = t0;
#pragma unroll
                for (int e = 0; e < 9; ++e) S.ts[e] = ts[e];
                pg8::EpiPlainBf16 E{(pg8::bf16_t*)(ws + WS_YS) + (size_t)t0 * 256 * DM, DM, 1.f / (SH8 * SD8)};
                pg8::gemm_phase<1>(lds + RING_OFF, g, S, E);
                if (nT > 256) {
                    pg8::Gemm gt{(const pg8::bf16_t*)(ws + WS_HC), (const pg8::bf16_t*)(ws + WS_MWDN), 256, (size_t)1024 * FF, 1, FF / 2};
                    pg8::TailOrder T; T.nunits = (nT - 256) * 28; T.G = G; T.c = bx;
#pragma unroll
                    for (int e = 0; e < 9; ++e) T.ts[e] = ts[e];
                    pg8::EpiTailF32 Et{(float*)(ws + WS_TAILP), 1.f / (SH8 * SD8)};
                    pg8::gemm_phase<1>(lds + RING_OFF, gt, T, Et);
                }
            }
            if (t0 + MOE_CHUNK_TILES < ntile) xcd_barrier(bar);
        }
    } SEAM(13);
    if (IN(14)) { combine_phase(P, ln_ffn_g + DM, ln_ffn_b + DM, vcu, G, lane, wave); }
#undef IN
#undef SEAM
}

extern "C" void kernel_launch(void* const* d_in, const int* in_sizes, int n_in, void* d_out, int out_size, void* d_ws, size_t ws_size, hipStream_t stream) {
    static int grid = 0;
    if (grid == 0) {
        if (n_in != 23 || in_sizes[0] != NTOK * DM || out_size != NTOK * DM || ws_size < WS_END) { fprintf(stderr, "kernel_launch: unexpected shapes (n_in %d, ws %zu)\n", n_in, ws_size); grid = -1; return; }
        int dev = 0, cus = 0, per_cu = 0;
        if (hipGetDevice(&dev) != hipSuccess || hipDeviceGetAttribute(&cus, hipDeviceAttributeMultiprocessorCount, dev) != hipSuccess) { grid = -1; return; }
        if (hipFuncSetAttribute((const void*)fwd_kernel, hipFuncAttributeMaxDynamicSharedMemorySize, LDS_BYTES) != hipSuccess) { grid = -1; return; }
        if (hipOccupancyMaxActiveBlocksPerMultiprocessor(&per_cu, (const void*)fwd_kernel, NTHR, LDS_BYTES) != hipSuccess || per_cu < 1) fprintf(stderr, "kernel_launch: occupancy query says %d\n", per_cu);
        (void)hipGetLastError();
        grid = cus;
    }
    if (grid < 0) return;
    if (hipMemsetAsync((char*)d_ws + WS_CTL, 0, CTL_ZERO_BYTES, stream) != hipSuccess) return;
    Args a{};
    for (int i = 0; i < 23; ++i) a.in[i] = (const float*)d_in[i];
    a.out = (float*)d_out; a.ws = (unsigned char*)d_ws;
    for (int j = 0; j < 32; ++j) a.inv_freq[j] = (float)pow(10000.0, -(double)j / 32.0);
    constexpr int NL = MK_N_LAUNCHES;
    static_assert(NL == 1 || NL == NPH, "MK_N_LAUNCHES is 1 or NPH");
#ifdef PROBE_PRE_HI
    a.ph_lo = PROBE_PRE_LO; a.ph_hi = PROBE_PRE_HI; a.li = 20; hipLaunchKernelGGL(fwd_kernel, dim3(grid), dim3(NTHR), LDS_BYTES, stream, a);
#endif
    for (int li = 0; li < NL; ++li) {
        a.ph_lo = (NL == 1) ? 0 : li; a.ph_hi = (NL == 1) ? NPH : li + 1; a.li = li;
        hipLaunchKernelGGL(fwd_kernel, dim3(grid), dim3(NTHR), LDS_BYTES, stream, a);
    }
}
```
